# Optimizing an MI355X kernel written in HIP

```python
import math
import jax, jax.numpy as jnp
from jax import lax
import numpy as np

D_MODEL = 1024
BATCH = 8
SEQ = 4096
DEPTH = 1
DEC_BATCH = 8
DEC_SEQ = 2048
PAST_LEN = 128

D_FF = 2816
D_SSM = D_MODEL // 2
SSM_GROUP = 16
N_SSM_GROUPS = D_SSM // SSM_GROUP
SSM_STATE = 64
N_HEADS = 8
QK_NOPE = 64
QK_ROPE = 32
V_HEAD = 64
D_ATTN = N_HEADS * V_HEAD
Q_RANK = (3 * D_MODEL) // 8
KV_RANK = D_MODEL // 4
D_IN = D_SSM + Q_RANK + KV_RANK + QK_ROPE
D_MIX = D_SSM + D_ATTN
Q_BLOCK = 128
ROPE_THETA = 10000.0
EPS = 1e-6
DT_MIN = 1e-3
DT_MAX = 1e-1

kernel_name = 'hybrid_s5_mla_macaron_encoder'

F32 = jnp.float32


def rms_norm(x, g):
    xf = x.astype(F32)
    y = xf * lax.rsqrt(jnp.mean(xf * xf, axis=-1, keepdims=True) + EPS)
    return (y * g.astype(F32)).astype(x.dtype)


def swiglu(x, w_gate, w_up, w_down):
    return (jax.nn.silu(x @ w_gate) * (x @ w_up)) @ w_down


def rope_tables(length):
    inv = 1.0 / (ROPE_THETA ** (jnp.arange(0, QK_ROPE, 2, dtype=F32) / QK_ROPE))
    ang = jnp.arange(length, dtype=F32)[:, None] * inv[None, :]
    return jnp.cos(ang), jnp.sin(ang)


def apply_rope(x, cos, sin):
    x1, x2 = jnp.split(x.astype(F32), 2, axis=-1)
    return jnp.concatenate([x1 * cos - x2 * sin, x1 * sin + x2 * cos], axis=-1).astype(x.dtype)


def _linear_recurrence(e1, e2):
    a1, b1 = e1
    a2, b2 = e2
    return a1 * a2, a2 * b1 + b2


def ssm_direction(u_c, lam_re, lam_im, log_dt, b_re, b_im, c_re, c_im, reverse):
    lam = lax.complex(lam_re.astype(F32), lam_im.astype(F32))
    dt = jnp.exp(log_dt.astype(F32))[:, None]
    lam_bar = jnp.exp(lam * dt)
    b_mat = lax.complex(b_re.astype(F32), b_im.astype(F32))
    b_bar = ((lam_bar - 1.0) / lam)[..., None] * b_mat
    bu = jnp.einsum('blgc,gpc->blgp', u_c, b_bar)
    a = jnp.broadcast_to(lam_bar, bu.shape)
    _, s = lax.associative_scan(_linear_recurrence, (a, bu), axis=1, reverse=reverse)
    c_mat = lax.complex(c_re.astype(F32), c_im.astype(F32))
    return jnp.real(jnp.einsum('blgp,gcp->blgc', s, c_mat))


def s5_mixer(u, fwd, bwd, d_skip, w_glu, b_glu):
    bsz, length, _ = u.shape
    ug = u.reshape(bsz, length, N_SSM_GROUPS, SSM_GROUP).astype(F32)
    u_c = ug.astype(jnp.complex64)
    y = (ssm_direction(u_c, *fwd, reverse=False)
         + ssm_direction(u_c, *bwd, reverse=True)
         + d_skip.astype(F32).reshape(N_SSM_GROUPS, SSM_GROUP) * ug)
    y = jax.nn.gelu(y.reshape(bsz, length, D_SSM)).astype(u.dtype)
    return y * jax.nn.sigmoid(y @ w_glu + b_glu)


def mla_mixer(q_c, kv_c, k_rope, g_q, w_uq, g_kv, w_ukv):
    bsz, length, _ = q_c.shape
    q = (rms_norm(q_c, g_q) @ w_uq).reshape(bsz, length, N_HEADS, QK_NOPE + QK_ROPE)
    kv = (rms_norm(kv_c, g_kv) @ w_ukv).reshape(bsz, length, N_HEADS, QK_NOPE + V_HEAD)
    cos, sin = rope_tables(length)
    scale = (QK_NOPE + QK_ROPE) ** -0.5
    q_nope = q[..., :QK_NOPE] * scale
    q_pe = apply_rope(q[..., QK_NOPE:], cos[:, None, :], sin[:, None, :]) * scale
    k_pe = apply_rope(k_rope, cos, sin)
    k_nope, v = kv[..., :QK_NOPE], kv[..., QK_NOPE:]
    n_blk = length // Q_BLOCK
    qn_b = q_nope.reshape(bsz, n_blk, Q_BLOCK, N_HEADS, QK_NOPE).transpose(1, 0, 2, 3, 4)
    qp_b = q_pe.reshape(bsz, n_blk, Q_BLOCK, N_HEADS, QK_ROPE).transpose(1, 0, 2, 3, 4)

    def attend(blk):
        qn, qp = blk
        s = (jnp.einsum('bqhd,bkhd->bhqk', qn, k_nope, preferred_element_type=F32)
             + jnp.einsum('bqhr,bkr->bhqk', qp, k_pe, preferred_element_type=F32))
        p = jax.nn.softmax(s, axis=-1).astype(v.dtype)
        return jnp.einsum('bhqk,bkhd->bqhd', p, v)

    o = lax.map(attend, (qn_b, qp_b))
    return o.transpose(1, 0, 2, 3, 4).reshape(bsz, length, D_ATTN)


def setup_inputs(seed: int = 0) -> dict:
    key = jax.random.key(seed)
    ks = iter(jax.random.split(key, 64))

    def nrm(shape, scale):
        return scale * jax.random.normal(next(ks), shape, dtype=F32)

    def gain(n):
        return 1.0 + nrm((DEPTH, n), 0.02)

    G, P, C = N_SSM_GROUPS, SSM_STATE, SSM_GROUP

    def ssm_dir():
        lam_re = -0.5 + nrm((DEPTH, G, P), 0.01)
        lam_im = math.pi * jnp.arange(P, dtype=F32)[None, None, :] + nrm((DEPTH, G, P), 0.01)
        log_dt = jax.random.uniform(next(ks), (DEPTH, G), F32, math.log(DT_MIN), math.log(DT_MAX))
        b_re = nrm((DEPTH, G, P, C), (2.0 * C) ** -0.5)
        b_im = nrm((DEPTH, G, P, C), (2.0 * C) ** -0.5)
        c_re = nrm((DEPTH, G, C, P), (2.0 * P) ** -0.5)
        c_im = nrm((DEPTH, G, C, P), (2.0 * P) ** -0.5)
        return lam_re, lam_im, log_dt, b_re, b_im, c_re, c_im

    x_prompt = nrm((BATCH, SEQ, D_MODEL), 1.0)
    x_sample = nrm((DEC_BATCH, DEC_SEQ, D_MODEL), 1.0)
    g_ffn1_pre = gain(D_MODEL)
    w_ffn1_gate = nrm((DEPTH, D_MODEL, D_FF), D_MODEL ** -0.5)
    w_ffn1_up = nrm((DEPTH, D_MODEL, D_FF), D_MODEL ** -0.5)
    w_ffn1_down = nrm((DEPTH, D_FF, D_MODEL), D_FF ** -0.5)
    g_ffn1_post = gain(D_MODEL)
    g_mix_pre = gain(D_MODEL)
    w_in = nrm((DEPTH, D_MODEL, D_IN), D_MODEL ** -0.5)
    lam_re_fwd, lam_im_fwd, log_dt_fwd, b_re_fwd, b_im_fwd, c_re_fwd, c_im_fwd = ssm_dir()
    lam_re_bwd, lam_im_bwd, log_dt_bwd, b_re_bwd, b_im_bwd, c_re_bwd, c_im_bwd = ssm_dir()
    d_skip = nrm((DEPTH, D_SSM), 1.0)
    w_glu = nrm((DEPTH, D_SSM, D_SSM), D_SSM ** -0.5)
    b_glu = nrm((DEPTH, D_SSM), 0.02)
    g_ssm_out = gain(D_SSM)
    g_q = gain(Q_RANK)
    w_uq = nrm((DEPTH, Q_RANK, N_HEADS * (QK_NOPE + QK_ROPE)), Q_RANK ** -0.5)
    g_kv = gain(KV_RANK)
    w_ukv = nrm((DEPTH, KV_RANK, N_HEADS * (QK_NOPE + V_HEAD)), KV_RANK ** -0.5)
    g_att_out = gain(D_ATTN)
    w_out = nrm((DEPTH, D_MIX, D_MODEL), D_MIX ** -0.5)
    g_mix_post = gain(D_MODEL)
    g_ffn2_pre = gain(D_MODEL)
    w_ffn2_gate = nrm((DEPTH, D_MODEL, D_FF), D_MODEL ** -0.5)
    w_ffn2_up = nrm((DEPTH, D_MODEL, D_FF), D_MODEL ** -0.5)
    w_ffn2_down = nrm((DEPTH, D_FF, D_MODEL), D_FF ** -0.5)
    g_ffn2_post = gain(D_MODEL)
    return {
        'x_prompt': x_prompt, 'x_sample': x_sample,
        'g_ffn1_pre': g_ffn1_pre, 'w_ffn1_gate': w_ffn1_gate, 'w_ffn1_up': w_ffn1_up,
        'w_ffn1_down': w_ffn1_down, 'g_ffn1_post': g_ffn1_post,
        'g_mix_pre': g_mix_pre, 'w_in': w_in,
        'lam_re_fwd': lam_re_fwd, 'lam_im_fwd': lam_im_fwd, 'log_dt_fwd': log_dt_fwd,
        'b_re_fwd': b_re_fwd, 'b_im_fwd': b_im_fwd, 'c_re_fwd': c_re_fwd, 'c_im_fwd': c_im_fwd,
        'lam_re_bwd': lam_re_bwd, 'lam_im_bwd': lam_im_bwd, 'log_dt_bwd': log_dt_bwd,
        'b_re_bwd': b_re_bwd, 'b_im_bwd': b_im_bwd, 'c_re_bwd': c_re_bwd, 'c_im_bwd': c_im_bwd,
        'd_skip': d_skip, 'w_glu': w_glu, 'b_glu': b_glu, 'g_ssm_out': g_ssm_out,
        'g_q': g_q, 'w_uq': w_uq, 'g_kv': g_kv, 'w_ukv': w_ukv, 'g_att_out': g_att_out,
        'w_out': w_out, 'g_mix_post': g_mix_post,
        'g_ffn2_pre': g_ffn2_pre, 'w_ffn2_gate': w_ffn2_gate, 'w_ffn2_up': w_ffn2_up,
        'w_ffn2_down': w_ffn2_down, 'g_ffn2_post': g_ffn2_post,
    }


def reference(x_prompt, x_sample,
              g_ffn1_pre, w_ffn1_gate, w_ffn1_up, w_ffn1_down, g_ffn1_post,
              g_mix_pre, w_in,
              lam_re_fwd, lam_im_fwd, log_dt_fwd, b_re_fwd, b_im_fwd, c_re_fwd, c_im_fwd,
              lam_re_bwd, lam_im_bwd, log_dt_bwd, b_re_bwd, b_im_bwd, c_re_bwd, c_im_bwd,
              d_skip, w_glu, b_glu, g_ssm_out,
              g_q, w_uq, g_kv, w_ukv, g_att_out,
              w_out, g_mix_post,
              g_ffn2_pre, w_ffn2_gate, w_ffn2_up, w_ffn2_down, g_ffn2_post):

    def trunk(x):
        for l in range(DEPTH):
            h = rms_norm(x, g_ffn1_pre[l])
            x = x + 0.5 * rms_norm(swiglu(h, w_ffn1_gate[l], w_ffn1_up[l], w_ffn1_down[l]), g_ffn1_post[l])
            h = rms_norm(x, g_mix_pre[l])
            z = h @ w_in[l]
            u, q_c, kv_c, k_rope = jnp.split(
                z, [D_SSM, D_SSM + Q_RANK, D_SSM + Q_RANK + KV_RANK], axis=-1)
            fwd = (lam_re_fwd[l], lam_im_fwd[l], log_dt_fwd[l], b_re_fwd[l], b_im_fwd[l],
                   c_re_fwd[l], c_im_fwd[l])
            bwd = (lam_re_bwd[l], lam_im_bwd[l], log_dt_bwd[l], b_re_bwd[l], b_im_bwd[l],
                   c_re_bwd[l], c_im_bwd[l])
            y_ssm = rms_norm(s5_mixer(u, fwd, bwd, d_skip[l], w_glu[l], b_glu[l]), g_ssm_out[l])
            y_att = rms_norm(mla_mixer(q_c, kv_c, k_rope, g_q[l], w_uq[l], g_kv[l], w_ukv[l]),
                             g_att_out[l])
            m = jnp.concatenate([y_ssm, y_att], axis=-1) @ w_out[l]
            x = x + rms_norm(m, g_mix_post[l])
            h = rms_norm(x, g_ffn2_pre[l])
            x = x + 0.5 * rms_norm(swiglu(h, w_ffn2_gate[l], w_ffn2_up[l], w_ffn2_down[l]), g_ffn2_post[l])
        return x

    y_prompt = trunk(x_prompt)
    y_sample = trunk(x_sample)
    return (y_prompt, y_sample)
```

```cpp
#include <hip/hip_runtime.h>
#include <hip/hip_cooperative_groups.h>
#include <cstdio>
namespace cg = cooperative_groups;

#define DI __device__ __forceinline__
#define LAS __attribute__((address_space(3)))
typedef unsigned short bf16_t;
typedef short bf16x8 __attribute__((ext_vector_type(8)));
typedef short s16x4 __attribute__((ext_vector_type(4)));
typedef float f32x2 __attribute__((ext_vector_type(2)));
typedef float f32x4 __attribute__((ext_vector_type(4)));
typedef float f32x16 __attribute__((ext_vector_type(16)));
typedef unsigned u32x2 __attribute__((ext_vector_type(2)));
typedef unsigned u32x4 __attribute__((ext_vector_type(4)));
typedef __bf16 bf16x2_t __attribute__((ext_vector_type(2)));

constexpr int T = 49152, TP = 32768, LP = 4096, LS = 2048, D = 1024, DFF = 2816, DIN = 1184, DINP = 1280;
constexpr int LC = 32, NCH = T / LC;
constexpr float EPS = 1e-6f;

constexpr size_t SZ_WGU = (size_t)5632 * 1024 * 2, SZ_WD = (size_t)1024 * 2816 * 2;
constexpr size_t O_WGU1 = 0;
constexpr size_t O_WD1 = O_WGU1 + SZ_WGU;
constexpr size_t O_WIN = O_WD1 + SZ_WD;
constexpr size_t O_WUQ = O_WIN + (size_t)DINP * 1024 * 2;
constexpr size_t O_WUKV = O_WUQ + (size_t)768 * 384 * 2;
constexpr size_t O_WGLU = O_WUKV + (size_t)1024 * 256 * 2;
constexpr size_t O_WOUT = O_WGLU + (size_t)512 * 512 * 2;
constexpr size_t O_BS = O_WOUT + (size_t)1024 * 1024 * 2;
constexpr size_t O_MY = O_BS + (size_t)32 * 256 * 512 * 2;
constexpr size_t O_ROPE = O_MY + (size_t)32 * 512 * 768 * 2;
constexpr size_t O_LBP = O_ROPE + (size_t)4096 * 16 * 8;
constexpr size_t O_BB = O_LBP + (size_t)32 * 2 * 33 * 64 * 8;
constexpr size_t O_KTAB = O_BB + (size_t)32 * 2 * 64 * 16 * 8;
constexpr size_t O_H = O_KTAB + (size_t)32 * 2 * 32 * 256 * 4;
constexpr size_t O_R = O_H + (size_t)T * 1024 * 2;
constexpr size_t O_UA = O_R;
constexpr size_t O_WGU2 = O_R;
constexpr size_t O_WD2 = O_WGU2 + SZ_WGU;
constexpr size_t O_ZQ = O_UA + (size_t)32 * NCH * 768 * 2;
constexpr size_t O_S = O_ZQ + (size_t)T * 640 * 2;
constexpr size_t O_YG = O_S;
constexpr size_t O_Q = O_S + (size_t)32 * NCH * 256 * 4;
constexpr size_t O_KPE = O_Q + (size_t)T * 768 * 2;
constexpr size_t O_KN = O_KPE + (size_t)T * 32 * 2;
constexpr size_t O_VT = O_KN + (size_t)T * 512 * 2;
constexpr size_t O_END = O_VT + (size_t)T * 512 * 2;
constexpr size_t O_BAR = O_END;
constexpr size_t O_SS = O_BAR + 16384;
constexpr size_t O_SSQ = O_SS + (size_t)2 * T * 4;
constexpr size_t O_TOTAL = O_SSQ + (size_t)2 * T * 4;
constexpr size_t O_A = O_ZQ;
constexpr size_t O_M2 = O_ZQ;
constexpr size_t O_A2 = O_WD2 + SZ_WD;
constexpr size_t O_X2A = O_A2 + (size_t)T * DFF * 2;
constexpr int X2_ROWS_A = (int)((O_END - O_X2A) / 2048);
constexpr size_t O_X2B = O_BS;
static_assert(O_X2A < O_END && X2_ROWS_A > 0 && X2_ROWS_A < T, "x2 split");
static_assert(O_X2B + (size_t)(T - X2_ROWS_A) * 2048 <= O_H, "x2 tail fits in the SSM area");
static_assert(O_A + (size_t)T * DFF * 2 <= O_END, "ffn hidden fits");
static_assert(O_M2 + (size_t)T * 1024 * 4 <= O_END, "m2 fits");
static_assert(O_WD2 + SZ_WD <= O_ZQ, "ffn2 weights fit in UA area");

struct Params { const float* in[39]; float* out; unsigned char* ws; };

DI unsigned pk2(float a, float b) { f32x2 v = {a, b}; bf16x2_t r = __builtin_convertvector(v, bf16x2_t); return __builtin_bit_cast(unsigned, r); }
DI bf16_t f2bf(float a) { return (bf16_t)(pk2(a, 0.f) & 0xffffu); }
DI float bflo(unsigned u) { return __uint_as_float(u << 16); }
DI float bfhi(unsigned u) { return __uint_as_float(u & 0xffff0000u); }
DI float bf2f(bf16_t b) { return __uint_as_float(((unsigned)b) << 16); }
DI f32x4 ld_nt(const float* p) { return __builtin_nontemporal_load((const f32x4*)p); }
DI u32x2 ld_nt2(const bf16_t* p) { return __builtin_nontemporal_load((const u32x2*)p); }
DI void st_nt(float* p, f32x4 v) { __builtin_nontemporal_store(v, (f32x4*)p); }
DI void st_nt2(bf16_t* p, u32x2 v) { __builtin_nontemporal_store(v, (u32x2*)p); }
DI float wave_sum(float v) {
#pragma unroll
    for (int o = 32; o >= 1; o >>= 1) v += __shfl_xor(v, o);
    return v;
}
DI float fast_rcp(float x) { return __builtin_amdgcn_rcpf(x); }
DI float fast_exp(float x) { return __builtin_amdgcn_exp2f(x * 1.4426950408889634f); }
DI float sigmoidf_(float x) { return fast_rcp(1.0f + fast_exp(-x)); }
DI float siluf_(float x) { return x * sigmoidf_(x); }
DI float gelu_tanh(float x) { const float z = 0.7978845608028654f * (x + 0.044715f * x * x * x); return x * sigmoidf_(2.0f * z); }
DI void tokinfo(int row, int& tb, int& L, int& pos) {
    if (row < TP) { tb = row & ~(LP - 1); L = LP; pos = row & (LP - 1); }
    else { const int r = row - TP; tb = TP + (r & ~(LS - 1)); L = LS; pos = r & (LS - 1); }
}
DI double exp_d(double x) {
    const double y = x * (1.0 / 64.0);
    double p = 1.0 + y * (1.0 + y * 0.5 * (1.0 + y * (1.0 / 3) * (1.0 + y * 0.25 * (1.0 + y * 0.2 * (1.0 + y * (1.0 / 6) * (1.0 + y * (1.0 / 7) * (1.0 + y * 0.125 * (1.0 + y * (1.0 / 9) * (1.0 + y * 0.1)))))))));
#pragma unroll
    for (int i = 0; i < 6; ++i) p *= p;
    return p;
}
DI void sincos_d(double ang, double& s, double& c) {
    double t = ang * 0.15915494309189535; t -= rint(t);
    const double r = t * (6.283185307179586 * 0.125), r2 = r * r;
    s = r * (1.0 - r2 * (1.0 / 6) * (1.0 - r2 * (1.0 / 20) * (1.0 - r2 * (1.0 / 42) * (1.0 - r2 * (1.0 / 72) * (1.0 - r2 * (1.0 / 110))))));
    c = 1.0 - r2 * 0.5 * (1.0 - r2 * (1.0 / 12) * (1.0 - r2 * (1.0 / 30) * (1.0 - r2 * (1.0 / 56) * (1.0 - r2 * (1.0 / 90)))));
#pragma unroll
    for (int i = 0; i < 3; ++i) { const double s2 = 2.0 * s * c, c2 = 1.0 - 2.0 * s * s; s = s2; c = c2; }
}

template <int MODE> DI int rowmap(int n) {
    if (MODE == 1) return ((n >> 7) << 8) + (n & 127);
    if (MODE == 2) return ((n >> 7) << 8) + 128 + (n & 127);
    if (MODE == 3) { const int h = n / 96, d = n - h * 96; const int dd = d < 64 ? d : (d < 80 ? 64 + 2 * (d - 64) : 65 + 2 * (d - 80)); return h * 96 + dd; }
    if (MODE == 4) return n < 1152 ? n : (n < 1168 ? 1152 + 2 * (n - 1152) : 1153 + 2 * (n - 1168));
    return n;
}
template <int MODE> DI void conv_T(const float* __restrict__ W, int K, int N, bf16_t* __restrict__ Wt, float* tile, const float* ga = nullptr, const float* gb = nullptr, int ksplit = 0) {
    const int tid = threadIdx.x, nkt = K / 64, nnt = (N + 63) / 64, ntl = nkt * nnt;
    auto ldtile = [&](int t, f32x4 (&v)[2]) { const int kt = t % nkt, ntile = t / nkt, k0 = kt * 64, n0 = ntile * 64;
#pragma unroll
        for (int r = 0; r < 2; ++r) { const int kl = (tid >> 4) + 32 * r, n = n0 + (tid & 15) * 4;
            v[r] = n < N ? ld_nt(W + (size_t)(k0 + kl) * N + n) : (f32x4){0.f, 0.f, 0.f, 0.f};
            if (ga) { const int k = k0 + kl; v[r] *= (k < ksplit ? ga[k] : gb[k - ksplit]); } } };
    f32x4 cur[2], nxt[2];
    int t = blockIdx.x;
    if (t < ntl) ldtile(t, cur);
    for (; t < ntl; t += gridDim.x) {
        const int kt = t % nkt, ntile = t / nkt, k0 = kt * 64, n0 = ntile * 64;
        const bool more = t + (int)gridDim.x < ntl;
        if (more) ldtile(t + gridDim.x, nxt);
        __syncthreads();
#pragma unroll
        for (int r = 0; r < 2; ++r) { const int kl = (tid >> 4) + 32 * r, nl = (tid & 15) * 4;
            tile[kl * 65 + nl] = cur[r][0]; tile[kl * 65 + nl + 1] = cur[r][1]; tile[kl * 65 + nl + 2] = cur[r][2]; tile[kl * 65 + nl + 3] = cur[r][3]; }
        __syncthreads();
#pragma unroll
        for (int r = 0; r < 2; ++r) { const int nl = (tid >> 4) + 32 * r, kq = (tid & 15) * 4, n = n0 + nl;
            if (n < N) { u32x2 o; o.x = pk2(tile[kq * 65 + nl], tile[(kq + 1) * 65 + nl]); o.y = pk2(tile[(kq + 2) * 65 + nl], tile[(kq + 3) * 65 + nl]);
                *(u32x2*)(Wt + (size_t)rowmap<MODE>(n) * K + k0 + kq) = o; } }
        if (more) { cur[0] = nxt[0]; cur[1] = nxt[1]; }
    }
}

constexpr int NR = 4;
DI void rowpass_first(const Params& p) {
    const int wid = threadIdx.x >> 6, lane = threadIdx.x & 63, stride = gridDim.x * 8;
    bf16_t* h = (bf16_t*)(p.ws + O_H);
    const float* g = p.in[2];
    for (int row0 = blockIdx.x * 8 + wid; row0 < T; row0 += NR * stride) {
        f32x4 v[NR][4]; float ss[NR];
#pragma unroll
        for (int r = 0; r < NR; ++r) { const int row = row0 + r * stride; ss[r] = 0.f;
            if (row < T) { const float* xr = row < TP ? p.in[0] + (size_t)row * D : p.in[1] + (size_t)(row - TP) * D;
#pragma unroll
                for (int i = 0; i < 4; ++i) v[r][i] = ld_nt(xr + (lane + 64 * i) * 4); } }
#pragma unroll
        for (int r = 0; r < NR; ++r) { const int row = row0 + r * stride;
            if (row < T) {
#pragma unroll
                for (int i = 0; i < 4; ++i) ss[r] += v[r][i][0] * v[r][i][0] + v[r][i][1] * v[r][i][1] + v[r][i][2] * v[r][i][2] + v[r][i][3] * v[r][i][3];
                ss[r] = wave_sum(ss[r]);
                const float rstd = rsqrtf(ss[r] * (1.0f / D) + EPS);
#pragma unroll
                for (int i = 0; i < 4; ++i) { const f32x4 gg = *(const f32x4*)(g + (lane + 64 * i) * 4);
                    u32x2 o; o.x = pk2(v[r][i][0] * rstd * gg[0], v[r][i][1] * rstd * gg[1]); o.y = pk2(v[r][i][2] * rstd * gg[2], v[r][i][3] * rstd * gg[3]);
                    *(u32x2*)(h + (size_t)row * D + (lane + 64 * i) * 4) = o; } } }
    }
}
DI bf16_t* x2_row(unsigned char* ws, int row) { return row < X2_ROWS_A ? (bf16_t*)(ws + O_X2A) + (size_t)row * D : (bf16_t*)(ws + O_X2B) + (size_t)(row - X2_ROWS_A) * D; }
template <int STAGE> DI void rowpass_res(const Params& p, const bf16_t* msrc, float alpha, const float* gpost, const float* gnext, bf16_t* h) {
    const int wid = threadIdx.x >> 6, lane = threadIdx.x & 63, stride = gridDim.x * 8;
    for (int row0 = blockIdx.x * 8 + wid; row0 < T; row0 += NR * stride) {
        f32x4 m[NR][4], x[NR][4];
#pragma unroll
        for (int r = 0; r < NR; ++r) { const int row = row0 + r * stride;
            if (row < T) {
#pragma unroll
                for (int i = 0; i < 4; ++i) { const u32x2 u = ld_nt2(msrc + (size_t)row * D + (lane + 64 * i) * 4); m[r][i][0] = bflo(u.x); m[r][i][1] = bfhi(u.x); m[r][i][2] = bflo(u.y); m[r][i][3] = bfhi(u.y); }
#pragma unroll
                for (int i = 0; i < 4; ++i) {
                    if (STAGE == 0) { const float* xr = row < TP ? p.in[0] + (size_t)row * D : p.in[1] + (size_t)(row - TP) * D; x[r][i] = ld_nt(xr + (lane + 64 * i) * 4); }
                    else { const bf16_t* xr = STAGE == 1 ? (const bf16_t*)p.out + (size_t)row * D : x2_row(p.ws, row);
                        const u32x2 u = ld_nt2(xr + (lane + 64 * i) * 4); x[r][i][0] = bflo(u.x); x[r][i][1] = bfhi(u.x); x[r][i][2] = bflo(u.y); x[r][i][3] = bfhi(u.y); } } } }
#pragma unroll
        for (int r = 0; r < NR; ++r) { const int row = row0 + r * stride;
            if (row < T) {
                float ss = 0.f;
#pragma unroll
                for (int i = 0; i < 4; ++i) ss += m[r][i][0] * m[r][i][0] + m[r][i][1] * m[r][i][1] + m[r][i][2] * m[r][i][2] + m[r][i][3] * m[r][i][3];
                ss = wave_sum(ss);
                const float rstd = rsqrtf(ss * (1.0f / D) + EPS) * alpha;
                float s2 = 0.f;
#pragma unroll
                for (int i = 0; i < 4; ++i) {
                    const f32x4 gg = *(const f32x4*)(gpost + (lane + 64 * i) * 4);
                    m[r][i] = x[r][i] + m[r][i] * rstd * gg; s2 += m[r][i][0] * m[r][i][0] + m[r][i][1] * m[r][i][1] + m[r][i][2] * m[r][i][2] + m[r][i][3] * m[r][i][3];
                    if (STAGE == 2) st_nt(p.out + (size_t)row * D + (lane + 64 * i) * 4, m[r][i]);
                    else { bf16_t* xo = STAGE == 0 ? (bf16_t*)p.out + (size_t)row * D : x2_row(p.ws, row);
                        u32x2 o; o.x = pk2(m[r][i][0], m[r][i][1]); o.y = pk2(m[r][i][2], m[r][i][3]); st_nt2(xo + (lane + 64 * i) * 4, o); }
                }
                if (STAGE != 2) {
                    s2 = wave_sum(s2);
                    const float r2 = rsqrtf(s2 * (1.0f / D) + EPS);
#pragma unroll
                    for (int i = 0; i < 4; ++i) { const f32x4 gg = *(const f32x4*)(gnext + (lane + 64 * i) * 4);
                        u32x2 o; o.x = pk2(m[r][i][0] * r2 * gg[0], m[r][i][1] * r2 * gg[1]); o.y = pk2(m[r][i][2] * r2 * gg[2], m[r][i][3] * r2 * gg[3]);
                        *(u32x2*)(h + (size_t)row * D + (lane + 64 * i) * 4) = o; }
                } } }
    }
}
DI void unpack8(const u32x4 u, float* f) { f[0] = bflo(u.x); f[1] = bfhi(u.x); f[2] = bflo(u.y); f[3] = bfhi(u.y); f[4] = bflo(u.z); f[5] = bfhi(u.z); f[6] = bflo(u.w); f[7] = bfhi(u.w); }
DI void rowpass_cat(const Params& p) {
    const int wid = threadIdx.x >> 6, lane = threadIdx.x & 63;
    bf16_t* cat = (bf16_t*)(p.ws + O_H);
    for (int row = blockIdx.x * 8 + wid; row < T; row += gridDim.x * 8) {
#pragma unroll
        for (int hf = 0; hf < 2; ++hf) {
            bf16_t* cr = cat + (size_t)row * 1024 + hf * 512 + lane * 8; const float* g = (hf ? p.in[31] : p.in[26]) + lane * 8;
            float v[8]; unpack8(*(const u32x4*)cr, v); float ss = 0.f;
#pragma unroll
            for (int i = 0; i < 8; ++i) ss += v[i] * v[i];
            ss = wave_sum(ss); const float rs = rsqrtf(ss * (1.0f / 512) + EPS);
            const f32x4 g0 = *(const f32x4*)g, g1 = *(const f32x4*)(g + 4);
            u32x4 o; o.x = pk2(v[0] * rs * g0[0], v[1] * rs * g0[1]); o.y = pk2(v[2] * rs * g0[2], v[3] * rs * g0[3]); o.z = pk2(v[4] * rs * g1[0], v[5] * rs * g1[1]); o.w = pk2(v[6] * rs * g1[2], v[7] * rs * g1[3]);
            *(u32x4*)cr = o;
        }
    }
}

DI void tables_phase0(const Params& p) {
    const int gtid = blockIdx.x * blockDim.x + threadIdx.x, gsz = gridDim.x * blockDim.x;
    f32x2* rope = (f32x2*)(p.ws + O_ROPE); f32x2* lbp = (f32x2*)(p.ws + O_LBP); f32x2* bb = (f32x2*)(p.ws + O_BB);
    for (int idx = gtid; idx < 4096 * 16; idx += gsz) { const int pos = idx >> 4, i = idx & 15;
        const double inv = exp_d(-(double)i * 0.5756462732485115); double s, c; sincos_d((double)pos * inv, s, c); rope[idx] = (f32x2){(float)c, (float)s}; }
    for (int idx = gtid; idx < 32 * 2 * 33 * 64; idx += gsz) { const int pp = idx & 63, e = (idx >> 6) % 33, gd = idx / (64 * 33), dir = gd & 1, g = gd >> 1;
        const double re = p.in[dir ? 16 : 9][g * 64 + pp], im = p.in[dir ? 17 : 10][g * 64 + pp], dt = exp_d((double)p.in[dir ? 18 : 11][g]);
        const double mag = exp_d((double)e * re * dt); double s, c; sincos_d((double)e * im * dt, s, c); lbp[idx] = (f32x2){(float)(mag * c), (float)(mag * s)}; }
    for (int idx = gtid; idx < 32 * 2 * 64 * 16; idx += gsz) { const int j = idx & 15, pp = (idx >> 4) & 63, dir = (idx >> 10) & 1, g = idx >> 11;
        const double re = p.in[dir ? 16 : 9][g * 64 + pp], im = p.in[dir ? 17 : 10][g * 64 + pp], dt = exp_d((double)p.in[dir ? 18 : 11][g]);
        const double mag = exp_d(re * dt); double s, c; sincos_d(im * dt, s, c);
        const double nr = mag * c - 1.0, ni = mag * s, den = 1.0 / (re * re + im * im);
        const double qr = (nr * re + ni * im) * den, qi = (ni * re - nr * im) * den;
        const double br = p.in[dir ? 19 : 12][(g * 64 + pp) * 16 + j], bi = p.in[dir ? 20 : 13][(g * 64 + pp) * 16 + j];
        bb[idx] = (f32x2){(float)(qr * br - qi * bi), (float)(qr * bi + qi * br)}; }
}
DI void ktab_phase(const Params& p) {
    const int gtid = blockIdx.x * blockDim.x + threadIdx.x, gsz = gridDim.x * blockDim.x;
    const f32x2* lbp = (const f32x2*)(p.ws + O_LBP); const f32x2* bb = (const f32x2*)(p.ws + O_BB); float* kt = (float*)(p.ws + O_KTAB);
    for (int idx = gtid; idx < 32 * 2 * 32 * 256; idx += gsz) { const int j = idx & 15, i = (idx >> 4) & 15, d = (idx >> 8) & 31, dir = (idx >> 13) & 1, g = idx >> 14;
        const float* cre = p.in[dir ? 21 : 14] + (g * 16 + i) * 64; const float* cim = p.in[dir ? 22 : 15] + (g * 16 + i) * 64;
        const f32x2* lb = lbp + ((g * 2 + dir) * 33 + d) * 64; const f32x2* b = bb + (g * 2 + dir) * 64 * 16 + j;
        float acc = 0.f;
        for (int pp = 0; pp < 64; ++pp) { const float cr = cre[pp], ci = cim[pp]; const f32x2 l = lb[pp], bv = b[pp * 16];
            const float wr = cr * l.x - ci * l.y, wi = cr * l.y + ci * l.x; acc += wr * bv.x - wi * bv.y; }
        kt[idx] = acc; }
}
DI void expand_phase(const Params& p) {
    const int gtid = blockIdx.x * blockDim.x + threadIdx.x, gsz = gridDim.x * blockDim.x;
    const f32x2* lbp = (const f32x2*)(p.ws + O_LBP); const f32x2* bb = (const f32x2*)(p.ws + O_BB); const float* kt = (const float*)(p.ws + O_KTAB);
    bf16_t* Bs = (bf16_t*)(p.ws + O_BS); bf16_t* My = (bf16_t*)(p.ws + O_MY);
    for (int o8 = gtid; o8 < 32 * 256 * 512 / 8; o8 += gsz) { const int idx = o8 * 8, k = idx & 511, n = (idx >> 9) & 255, g = idx >> 17;
        const int s = k >> 4, j = k & 15, dr = n >> 6, dir = dr >> 1, reim = dr & 1, pp = n & 63, e = dir ? s : 31 - s;
        const f32x2 l = lbp[((g * 2 + dir) * 33 + e) * 64 + pp]; const f32x4* bq = (const f32x4*)(bb + ((g * 2 + dir) * 64 + pp) * 16 + j);
        float v[8];
#pragma unroll
        for (int q = 0; q < 4; ++q) { const f32x4 b2 = bq[q];
            v[2 * q] = reim ? (l.x * b2[1] + l.y * b2[0]) : (l.x * b2[0] - l.y * b2[1]); v[2 * q + 1] = reim ? (l.x * b2[3] + l.y * b2[2]) : (l.x * b2[2] - l.y * b2[3]); }
        u32x4 w; w.x = pk2(v[0], v[1]); w.y = pk2(v[2], v[3]); w.z = pk2(v[4], v[5]); w.w = pk2(v[6], v[7]);
        *(u32x4*)(Bs + idx) = w; }
    for (int o8 = gtid; o8 < 32 * 512 * 768 / 8; o8 += gsz) { const int row = o8 / 96, k = (o8 - row * 96) * 8, n = row & 511, g = row >> 9, t = n >> 4, i = n & 15;
        float v[8];
        if (k < 512) { const int s = k >> 4, j = k & 15; const float* kg = kt + (size_t)g * 2 * 32 * 256 + i * 16 + j;
            if (t != s) { const float* q = t > s ? kg + (t - s) * 256 : kg + 32 * 256 + (s - t) * 256; const f32x4 a0 = *(const f32x4*)q, a1 = *(const f32x4*)(q + 4);
                v[0] = a0[0]; v[1] = a0[1]; v[2] = a0[2]; v[3] = a0[3]; v[4] = a1[0]; v[5] = a1[1]; v[6] = a1[2]; v[7] = a1[3]; }
            else { const f32x4 a0 = *(const f32x4*)kg, a1 = *(const f32x4*)(kg + 4), c0 = *(const f32x4*)(kg + 32 * 256), c1 = *(const f32x4*)(kg + 32 * 256 + 4); const float dsk = p.in[23][g * 16 + i];
#pragma unroll
                for (int q = 0; q < 4; ++q) { v[q] = a0[q] + c0[q] + (i == j + q ? dsk : 0.f); v[4 + q] = a1[q] + c1[q] + (i == j + 4 + q ? dsk : 0.f); } } }
        else { const int kk = k - 512, dir = kk >> 7, reim = (kk >> 6) & 1, pp = kk & 63, e = dir ? 32 - t : t + 1;
            const float* crp = p.in[dir ? 21 : 14] + (g * 16 + i) * 64 + pp; const float* cip = p.in[dir ? 22 : 15] + (g * 16 + i) * 64 + pp; const f32x4* lq = (const f32x4*)(lbp + ((g * 2 + dir) * 33 + e) * 64 + pp);
            const f32x4 cr0 = *(const f32x4*)crp, cr1 = *(const f32x4*)(crp + 4), ci0 = *(const f32x4*)cip, ci1 = *(const f32x4*)(cip + 4);
#pragma unroll
            for (int q = 0; q < 4; ++q) { const f32x4 l2 = lq[q]; const float cra = q < 2 ? cr0[2 * q] : cr1[2 * q - 4], crb = q < 2 ? cr0[2 * q + 1] : cr1[2 * q - 3], cia = q < 2 ? ci0[2 * q] : ci1[2 * q - 4], cib = q < 2 ? ci0[2 * q + 1] : ci1[2 * q - 3];
                v[2 * q] = reim ? -(cra * l2[1] + cia * l2[0]) : (cra * l2[0] - cia * l2[1]); v[2 * q + 1] = reim ? -(crb * l2[3] + cib * l2[2]) : (crb * l2[2] - cib * l2[3]); } }
        u32x4 w; w.x = pk2(v[0], v[1]); w.y = pk2(v[2], v[3]); w.z = pk2(v[4], v[5]); w.w = pk2(v[6], v[7]);
        *(u32x4*)(My + (size_t)o8 * 8) = w; }
}
DI void scan_unit(const Params& p, int g, int pm) {
    const f32x2* lbp = (const f32x2*)(p.ws + O_LBP); const float* S = (const float*)(p.ws + O_S); bf16_t* UA = (bf16_t*)(p.ws + O_UA);
    const int tid = threadIdx.x, pp = tid & 63, dir = (tid >> 6) & 1, sub = tid >> 7;
    const int nc = pm < 4 ? 128 : 64, nsub = pm < 4 ? 2 : 4;
    if (sub >= nsub) return;
    const int c0 = pm * 256 + sub * nc;
    const f32x2 lL = lbp[((g * 2 + dir) * 33 + 32) * 64 + pp];
    float ar = 0.f, ai = 0.f;
    const float* Sg = S + (size_t)g * NCH * 256 + dir * 128 + pp; bf16_t* Ug = UA + (size_t)g * NCH * 768 + 512 + dir * 128 + pp;
#pragma unroll 16
    for (int cc = 0; cc < nc; ++cc) { const int c = c0 + (dir ? nc - 1 - cc : cc);
        const float sr = Sg[(size_t)c * 256], si = Sg[(size_t)c * 256 + 64];
        Ug[(size_t)c * 768] = f2bf(ar); Ug[(size_t)c * 768 + 64] = f2bf(ai);
        const float nr = lL.x * ar - lL.y * ai + sr, ni = lL.x * ai + lL.y * ar + si; ar = nr; ai = ni; }
}

namespace pg8 {
constexpr int BM = 256, BK = 64, HALF = 128, HTB = HALF * BK * 2, STAGE_BYTES = 8 * HTB, NXCD = 8, WGM = 8;
DI int lds_byte(int r, int c) { const int st = (r >> 4) * 2 + (c >> 5), rr = r & 15, cc = c & 31, ob = rr * 64 + cc * 2; return st * 1024 + (ob ^ (((ob >> 9) & 1) << 5)); }
DI void stage_rc(int b, int& R, int& C) { const int st = b / 1024, sb = b % 1024, swz = sb ^ (((sb >> 9) & 1) << 5); R = (st >> 1) * 16 + swz / 64; C = (st & 1) * 32 + (swz % 64) / 2; }
DI int perm32(int rho) { const int n = rho >> 4, i = rho & 15; return 8 * (i >> 2) + 4 * n + (i & 3); }
struct Unit { int pm, pn, g; };
struct Gemm { const bf16_t* A; const bf16_t* Bt; int lda, ldb, K; size_t sA, sB; };
struct Order {
    int nM, nN, nB, nwg, G, c;
    DI void init(int M, int N, int nB_, int G_, int c_) { nM = M / BM; nN = N / BM; nB = nB_; nwg = nM * nN; G = G_; c = c_; }
    DI bool next(int i, Unit& u) const {
        const long L = (long)i * G + c; if (L >= (long)nwg * nB) return false;
        u.g = (int)(L / nwg); int wgid = (int)(L % nwg);
        if (nB == 1) {
            { const int q = nwg / NXCD, r = nwg % NXCD, xcd = wgid % NXCD, off = wgid / NXCD; wgid = (xcd < r ? xcd * (q + 1) : r * (q + 1) + (xcd - r) * q) + off; }
            const int nig = WGM * nN, gid = wgid / nig, fm = gid * WGM, gsz = (nM - fm) < WGM ? (nM - fm) : WGM;
            u.pm = fm + ((wgid % nig) % gsz); u.pn = (wgid % nig) / gsz;
        } else { u.pm = wgid % nM; u.pn = wgid / nM; }
        return true;
    }
};
template <class Epi>
DI void gemm_phase(LAS unsigned char* lds, const Gemm g, const Order& S, const Epi& E) {
    const int tid = threadIdx.x, wid = __builtin_amdgcn_readfirstlane(tid >> 6), lane = tid & 63, wr = wid >> 2, wc = wid & 3, fr = lane & 15, fq = lane >> 4;
    const int K = g.K, nt = K / BK;
    unsigned voffA[2], voffB[2];
#pragma unroll
    for (int i = 0; i < 2; ++i) { int R, C; stage_rc(tid * 16 + i * 8192, R, C); const int Rb = Epi::PERM ? ((R & ~31) + perm32(R & 31)) : R;
        voffA[i] = (unsigned)(R * g.lda + C) * 2u; voffB[i] = (unsigned)(Rb * g.ldb + C) * 2u; }
    const size_t kstep = (size_t)(BK * 2);
    const size_t hstepA = (size_t)HALF * g.lda * 2, hstepB = (size_t)HALF * g.ldb * 2;
    const size_t tstepA = 2 * hstepA, tstepB = 2 * hstepB;
    const unsigned ldsw = (unsigned)wid * 1024u;
    const int aoff = lds_byte(wr * 64 + fr, fq * 8), boff = lds_byte(wc * 32 + fr, fq * 8);
#define PG8_SA(b, h) (((b) * 2 + (h)) * HTB)
#define PG8_SB(b, h) ((4 + (b) * 2 + (h)) * HTB)
#define PG8_STAGE(bufoff, gbase, voff) do { _Pragma("unroll") for (int _i = 0; _i < 2; ++_i) \
        __builtin_amdgcn_global_load_lds((const unsigned*)((const char*)(gbase) + (voff)[_i]), (LAS unsigned*)(lds + (bufoff) + ldsw + _i * 8192), 16, 0, 0); } while (0)
#define PG8_LDA(dst, b, h) do { _Pragma("unroll") for (int m = 0; m < 4; ++m) _Pragma("unroll") for (int k = 0; k < 2; ++k) dst[m][k] = *(const LAS bf16x8*)(lds + PG8_SA(b, h) + aoff + m * 2048 + k * 1024); } while (0)
#define PG8_LDB(dst, b, h) do { _Pragma("unroll") for (int n = 0; n < 2; ++n) _Pragma("unroll") for (int k = 0; k < 2; ++k) dst[n][k] = *(const LAS bf16x8*)(lds + PG8_SB(b, h) + boff + n * 2048 + k * 1024); } while (0)
#define PG8_MMA(ai, bj, At, Bt) do { __builtin_amdgcn_s_setprio(1); _Pragma("unroll") for (int m = 0; m < 4; ++m) _Pragma("unroll") for (int n = 0; n < 2; ++n) _Pragma("unroll") for (int k = 0; k < 2; ++k) \
        acc[ai][bj][m][n] = __builtin_amdgcn_mfma_f32_16x16x32_bf16(Bt[n][k], At[m][k], acc[ai][bj][m][n], 0, 0, 0); __builtin_amdgcn_s_setprio(0); } while (0)
#define PG8_WAIT_V(n) asm volatile("s_waitcnt vmcnt(" #n ")" ::: "memory")
#define PG8_WAIT_L(n) asm volatile("s_waitcnt lgkmcnt(" #n ")" ::: "memory")
#define PG8_BAR __builtin_amdgcn_s_barrier()
#define PG8_SCHED __builtin_amdgcn_sched_barrier(0)
    Unit cur, nxt; int ui = 0;
    if (!S.next(0, cur)) return;
    f32x4 acc[2][2][4][2];
#pragma unroll
    for (int a = 0; a < 2; ++a)
#pragma unroll
        for (int b = 0; b < 2; ++b)
#pragma unroll
            for (int m = 0; m < 4; ++m)
#pragma unroll
                for (int n = 0; n < 2; ++n) acc[a][b][m][n] = (f32x4){0.f, 0.f, 0.f, 0.f};
    bf16x8 At[4][2], B0[2][2], B1[2][2];
    const char* cA = (const char*)g.A + (size_t)cur.g * g.sA * 2 + (size_t)cur.pm * tstepA; const char* cB = (const char*)g.Bt + (size_t)cur.g * g.sB * 2 + (size_t)cur.pn * tstepB;
    PG8_STAGE(PG8_SB(0, 0), cB, voffB); PG8_STAGE(PG8_SA(0, 0), cA, voffA); PG8_STAGE(PG8_SB(0, 1), cB + hstepB, voffB); PG8_STAGE(PG8_SA(0, 1), cA + hstepA, voffA);
    if (wr == 1) PG8_BAR;
    PG8_WAIT_V(4); PG8_BAR;
    PG8_STAGE(PG8_SB(1, 0), cB + kstep, voffB); PG8_STAGE(PG8_SA(1, 0), cA + kstep, voffA); PG8_STAGE(PG8_SB(1, 1), cB + hstepB + kstep, voffB);
    PG8_WAIT_V(6); PG8_BAR;
    for (;;) {
        const bool has_next = S.next(ui + 1, nxt);
        const char* nA = has_next ? (const char*)g.A + (size_t)nxt.g * g.sA * 2 + (size_t)nxt.pm * tstepA : cA; const char* nB = has_next ? (const char*)g.Bt + (size_t)nxt.g * g.sB * 2 + (size_t)nxt.pn * tstepB : cB;
#pragma unroll 1
        for (int t = 0; t < nt; t += 2) {
            const bool last = (t == nt - 2);
            const char* a1 = cA + (size_t)(t + 1) * kstep;
            const char* a2 = last ? nA : cA + (size_t)(t + 2) * kstep; const char* b2 = last ? nB : cB + (size_t)(t + 2) * kstep;
            const char* a3 = a2 + kstep; const char* b3 = b2 + kstep;
            if constexpr (Epi::MID) { if (t == (nt >> 1)) { int fr_ = fr, fq_ = fq; asm volatile("" : "+v"(fr_), "+v"(fq_)); E.mid(acc, cur, wr, wc, fr_, fq_); } }
            PG8_LDB(B0, 0, 0); PG8_SCHED; PG8_LDA(At, 0, 0); PG8_STAGE(PG8_SA(1, 1), a1 + hstepA, voffA);
            PG8_WAIT_L(8); PG8_BAR; PG8_WAIT_L(0); PG8_MMA(0, 0, At, B0); PG8_BAR; PG8_SCHED;
            PG8_LDB(B1, 0, 1); PG8_STAGE(PG8_SB(0, 0), b2, voffB);
            PG8_BAR; PG8_WAIT_L(0); PG8_MMA(0, 1, At, B1); PG8_BAR;
            PG8_LDA(At, 0, 1); PG8_STAGE(PG8_SA(0, 0), a2, voffA);
            PG8_BAR; PG8_WAIT_L(0); PG8_MMA(1, 0, At, B0); PG8_BAR; PG8_SCHED;
            PG8_STAGE(PG8_SB(0, 1), b2 + hstepB, voffB);
            PG8_WAIT_V(6); PG8_BAR; PG8_MMA(1, 1, At, B1); PG8_BAR;
            PG8_LDB(B0, 1, 0); PG8_SCHED; PG8_LDA(At, 1, 0); PG8_STAGE(PG8_SA(0, 1), a2 + hstepA, voffA);
            PG8_WAIT_L(8); PG8_BAR; PG8_WAIT_L(0); PG8_MMA(0, 0, At, B0); PG8_BAR; PG8_SCHED;
            PG8_LDB(B1, 1, 1); PG8_STAGE(PG8_SB(1, 0), b3, voffB);
            PG8_BAR; PG8_WAIT_L(0); PG8_MMA(0, 1, At, B1); PG8_BAR;
            PG8_LDA(At, 1, 1); PG8_STAGE(PG8_SA(1, 0), a3, voffA);
            PG8_BAR; PG8_WAIT_L(0); PG8_MMA(1, 0, At, B0); PG8_BAR; PG8_SCHED;
            PG8_STAGE(PG8_SB(1, 1), b3 + hstepB, voffB);
            PG8_WAIT_V(6); PG8_BAR; PG8_MMA(1, 1, At, B1); PG8_BAR;
        }
        { int fr_ = fr, fq_ = fq; asm volatile("" : "+v"(fr_), "+v"(fq_)); E(acc, cur, wr, wc, fr_, fq_); }
        if (!has_next) break;
#pragma unroll
        for (int a = 0; a < 2; ++a)
#pragma unroll
            for (int b = 0; b < 2; ++b)
#pragma unroll
                for (int m = 0; m < 4; ++m)
#pragma unroll
                    for (int n = 0; n < 2; ++n) acc[a][b][m][n] = (f32x4){0.f, 0.f, 0.f, 0.f};
        cur = nxt; cA = nA; cB = nB; ++ui;
    }
    PG8_WAIT_V(0);
    if (wr == 0) PG8_BAR;
    PG8_BAR;
#undef PG8_SA
#undef PG8_SB
#undef PG8_STAGE
#undef PG8_LDA
#undef PG8_LDB
#undef PG8_MMA
#undef PG8_WAIT_V
#undef PG8_WAIT_L
#undef PG8_BAR
#undef PG8_SCHED
}
typedef f32x4 Acc[2][2][4][2];

struct EpiF32 {
    static constexpr bool PERM = false, MID = false;
    float* C; int ldc; size_t sC;
    DI void operator()(const Acc& acc, const Unit& u, int wr, int wc, int fr, int fq) const {
        const int row0 = u.pm * BM + wr * 64 + fr, col0 = u.pn * BM + wc * 32 + 4 * fq;
        float* base = C + (size_t)u.g * sC;
#pragma unroll
        for (int ai = 0; ai < 2; ++ai)
#pragma unroll
            for (int m = 0; m < 4; ++m) { float* rowp = base + (size_t)(row0 + ai * HALF + m * 16) * ldc + col0;
#pragma unroll
                for (int bj = 0; bj < 2; ++bj)
#pragma unroll
                    for (int n = 0; n < 2; ++n) *(f32x4*)(rowp + bj * HALF + n * 16) = acc[ai][bj][m][n]; }
    }
};
DI u32x4 pack8(const f32x4 a, const f32x4 b) { u32x4 w; w.x = pk2(a[0], a[1]); w.y = pk2(a[2], a[3]); w.z = pk2(b[0], b[1]); w.w = pk2(b[2], b[3]); return w; }
struct EpiBf16 {
    static constexpr bool PERM = true, MID = false;
    bf16_t* O; int ldc;
    DI void operator()(const Acc& acc, const Unit& u, int wr, int wc, int fr, int fq) const {
        const int row0 = u.pm * BM + wr * 64 + fr, col0 = u.pn * BM + wc * 32 + 8 * fq;
#pragma unroll
        for (int ai = 0; ai < 2; ++ai)
#pragma unroll
            for (int m = 0; m < 4; ++m) { bf16_t* rowp = O + (size_t)(row0 + ai * HALF + m * 16) * ldc + col0;
#pragma unroll
                for (int bj = 0; bj < 2; ++bj) *(u32x4*)(rowp + bj * HALF) = pack8(acc[ai][bj][m][0], acc[ai][bj][m][1]); }
    }
};
struct EpiSwiGLU {
    static constexpr bool PERM = true, MID = false;
    bf16_t* O;
    DI void operator()(const Acc& acc, const Unit& u, int wr, int wc, int fr, int fq) const {
        const int row0 = u.pm * BM + wr * 64 + fr, col0 = u.pn * HALF + wc * 32 + 8 * fq;
#pragma unroll
        for (int ai = 0; ai < 2; ++ai)
#pragma unroll
            for (int m = 0; m < 4; ++m) { __builtin_amdgcn_sched_barrier(0); f32x4 v0, v1;
#pragma unroll
                for (int j = 0; j < 4; ++j) { v0[j] = siluf_(acc[ai][0][m][0][j]) * acc[ai][1][m][0][j]; v1[j] = siluf_(acc[ai][0][m][1][j]) * acc[ai][1][m][1][j]; }
                *(u32x4*)(O + (size_t)(row0 + ai * HALF + m * 16) * DFF + col0) = pack8(v0, v1); }
    }
};
struct EpiZ {
    static constexpr bool PERM = true, MID = false;
    bf16_t* UA; bf16_t* zq; bf16_t* kpe; float* ssq; const f32x2* rope;
    DI void operator()(const Acc& acc, const Unit& u, int wr, int wc, int fr, int fq) const {
        const int row0 = u.pm * BM + wr * 64 + fr;
#pragma unroll
        for (int ai = 0; ai < 2; ++ai)
#pragma unroll
            for (int m = 0; m < 4; ++m) { __builtin_amdgcn_sched_barrier(0); const int row = row0 + ai * HALF + m * 16;
#pragma unroll
                for (int bj = 0; bj < 2; ++bj) { const int c0 = u.pn * BM + bj * HALF + wc * 32 + 8 * fq; const f32x4 v0 = acc[ai][bj][m][0], v1 = acc[ai][bj][m][1];
                    if (c0 < 512) *(u32x4*)(UA + ((size_t)(c0 >> 4) * NCH + (row >> 5)) * 768 + (row & 31) * 16 + (c0 & 15)) = pack8(v0, v1);
                    else if (c0 < 1152) {
                        *(u32x4*)(zq + (size_t)row * 640 + (c0 - 512)) = pack8(v0, v1);
                        float s = v0[0] * v0[0] + v0[1] * v0[1] + v0[2] * v0[2] + v0[3] * v0[3] + v1[0] * v1[0] + v1[1] * v1[1] + v1[2] * v1[2] + v1[3] * v1[3];
                        s += __shfl_xor(s, 16); s += __shfl_xor(s, 32);
                        if (fq == 0) atomicAdd(ssq + (c0 < 896 ? 0 : T) + row, s);
                    } else if (c0 < 1184) {
                        int tb, L, pos; tokinfo(row, tb, L, pos); const f32x2* rp = rope + pos * 16 + ((c0 - 1152) >> 1);
                        const f32x2 c0_ = rp[0], c1_ = rp[1], c2_ = rp[2], c3_ = rp[3]; f32x4 w0, w1;
                        w0[0] = v0[0] * c0_.x - v0[1] * c0_.y; w0[1] = v0[0] * c0_.y + v0[1] * c0_.x; w0[2] = v0[2] * c1_.x - v0[3] * c1_.y; w0[3] = v0[2] * c1_.y + v0[3] * c1_.x;
                        w1[0] = v1[0] * c2_.x - v1[1] * c2_.y; w1[1] = v1[0] * c2_.y + v1[1] * c2_.x; w1[2] = v1[2] * c3_.x - v1[3] * c3_.y; w1[3] = v1[2] * c3_.y + v1[3] * c3_.x;
                        *(u32x4*)(kpe + (size_t)row * 32 + (c0 - 1152)) = pack8(w0, w1);
                    } } }
    }
};
struct EpiQ {
    static constexpr bool PERM = true, MID = false;
    bf16_t* Q; const f32x2* rope; float qs; const float* ssq;
    DI void operator()(const Acc& acc, const Unit& u, int wr, int wc, int fr, int fq) const {
        const int row0 = u.pm * BM + wr * 64 + fr;
#pragma unroll
        for (int ai = 0; ai < 2; ++ai)
#pragma unroll
            for (int m = 0; m < 4; ++m) { __builtin_amdgcn_sched_barrier(0); const int row = row0 + ai * HALF + m * 16; int tb, L, pos; tokinfo(row, tb, L, pos);
#pragma unroll
                for (int bj = 0; bj < 2; ++bj) { const int c0 = u.pn * BM + bj * HALF + wc * 32 + 8 * fq; const int head = c0 / 96, d0 = c0 - head * 96;
                    f32x4 v0 = acc[ai][bj][m][0], v1 = acc[ai][bj][m][1];
                    if (d0 >= 64) { const int i0 = (d0 - 64) >> 1; const f32x2* rp = rope + pos * 16 + i0;
                        const f32x2 c0_ = rp[0], c1_ = rp[1], c2_ = rp[2], c3_ = rp[3];
                        const f32x4 t0 = v0, t1 = v1;
                        v0[0] = t0[0] * c0_.x - t0[1] * c0_.y; v0[1] = t0[0] * c0_.y + t0[1] * c0_.x; v0[2] = t0[2] * c1_.x - t0[3] * c1_.y; v0[3] = t0[2] * c1_.y + t0[3] * c1_.x;
                        v1[0] = t1[0] * c2_.x - t1[1] * c2_.y; v1[1] = t1[0] * c2_.y + t1[1] * c2_.x; v1[2] = t1[2] * c3_.x - t1[3] * c3_.y; v1[3] = t1[2] * c3_.y + t1[3] * c3_.x; }
                    { const float f = qs * rsqrtf(ssq[row] * (1.0f / 384) + EPS); v0 *= f; v1 *= f; }
                    *(u32x4*)(Q + ((size_t)tb * 8 + (size_t)head * L + pos) * 96 + d0) = pack8(v0, v1); } }
    }
};
struct EpiKV {
    static constexpr bool PERM = true, MID = false;
    bf16_t* Kn; bf16_t* Vt; const float* sskv;
    DI void operator()(const Acc& acc, const Unit& u, int wr, int wc, int fr, int fq) const {
        const int row0 = u.pm * BM + wr * 64 + fr;
#pragma unroll
        for (int ai = 0; ai < 2; ++ai)
#pragma unroll
            for (int m = 0; m < 4; ++m) { __builtin_amdgcn_sched_barrier(0); const int row = row0 + ai * HALF + m * 16; int tb, L, pos; tokinfo(row, tb, L, pos);
                const float f = rsqrtf(sskv[row] * (1.0f / 256) + EPS);
#pragma unroll
                for (int bj = 0; bj < 2; ++bj) { const int c0 = u.pn * BM + bj * HALF + wc * 32 + 8 * fq; const int head = c0 >> 7, d0 = c0 & 127;
                    const f32x4 v0 = acc[ai][bj][m][0] * f, v1 = acc[ai][bj][m][1] * f;
                    if (d0 < 64) *(u32x4*)(Kn + ((size_t)tb * 8 + (size_t)head * L + pos) * 64 + d0) = pack8(v0, v1);
                    else { bf16_t* vp = Vt + (size_t)tb * 512 + (size_t)(head * 64 + d0 - 64) * L + pos;
#pragma unroll
                        for (int j = 0; j < 4; ++j) { vp[(size_t)j * L] = f2bf(v0[j]); vp[(size_t)(j + 4) * L] = f2bf(v1[j]); } } } }
    }
};
struct EpiY {
    static constexpr bool PERM = true, MID = false;
    bf16_t* yg;
    DI void operator()(const Acc& acc, const Unit& u, int wr, int wc, int fr, int fq) const {
        const int row0 = u.pm * BM + wr * 64 + fr;
#pragma unroll
        for (int ai = 0; ai < 2; ++ai)
#pragma unroll
            for (int m = 0; m < 4; ++m) { __builtin_amdgcn_sched_barrier(0); const int ch = row0 + ai * HALF + m * 16;
#pragma unroll
                for (int bj = 0; bj < 2; ++bj) { const int n0 = u.pn * BM + bj * HALF + wc * 32 + 8 * fq; f32x4 v0, v1;
#pragma unroll
                    for (int j = 0; j < 4; ++j) { v0[j] = gelu_tanh(acc[ai][bj][m][0][j]); v1[j] = gelu_tanh(acc[ai][bj][m][1][j]); }
                    *(u32x4*)(yg + ((size_t)ch * 32 + (n0 >> 4)) * 512 + u.g * 16 + (n0 & 15)) = pack8(v0, v1); } }
    }
};
struct EpiGLU {
    static constexpr bool PERM = true, MID = false;
    const bf16_t* yg; const float* bias; bf16_t* cat; float* ss;
    DI void operator()(const Acc& acc, const Unit& u, int wr, int wc, int fr, int fq) const {
        const int row0 = u.pm * BM + wr * 64 + fr;
#pragma unroll
        for (int ai = 0; ai < 2; ++ai)
#pragma unroll
            for (int m = 0; m < 4; ++m) { __builtin_amdgcn_sched_barrier(0); const int row = row0 + ai * HALF + m * 16; float ssl = 0.f;
#pragma unroll
                for (int bj = 0; bj < 2; ++bj) { const int c0 = u.pn * BM + bj * HALF + wc * 32 + 8 * fq;
                    float y[8]; unpack8(*(const u32x4*)(yg + (size_t)row * 512 + c0), y);
                    const f32x4 b0 = *(const f32x4*)(bias + c0), b1 = *(const f32x4*)(bias + c0 + 4); f32x4 v0, v1;
#pragma unroll
                    for (int j = 0; j < 4; ++j) { v0[j] = y[j] * sigmoidf_(acc[ai][bj][m][0][j] + b0[j]); v1[j] = y[4 + j] * sigmoidf_(acc[ai][bj][m][1][j] + b1[j]); ssl += v0[j] * v0[j] + v1[j] * v1[j]; }
                    *(u32x4*)(cat + (size_t)row * 1024 + c0) = pack8(v0, v1); }
                ssl += __shfl_xor(ssl, 16); ssl += __shfl_xor(ssl, 32);
                if (fq == 0) atomicAdd(ss + row, ssl); }
    }
};
struct EpiOut {
    static constexpr bool PERM = true, MID = true;
    bf16_t* O; const float* ss;
    DI void mid(Acc& acc, const Unit& u, int wr, int wc, int fr, int fq) const {
        const int row0 = u.pm * BM + wr * 64 + fr;
#pragma unroll
        for (int ai = 0; ai < 2; ++ai)
#pragma unroll
            for (int m = 0; m < 4; ++m) { const int row = row0 + ai * HALF + m * 16;
                const float f = rsqrtf(ss[row] * (1.0f / 512) + EPS) * sqrtf(ss[T + row] * (1.0f / 512) + EPS);
#pragma unroll
                for (int bj = 0; bj < 2; ++bj) { acc[ai][bj][m][0] *= f; acc[ai][bj][m][1] *= f; } }
    }
    DI void operator()(const Acc& acc, const Unit& u, int wr, int wc, int fr, int fq) const {
        const int row0 = u.pm * BM + wr * 64 + fr, col0 = u.pn * BM + wc * 32 + 8 * fq;
#pragma unroll
        for (int ai = 0; ai < 2; ++ai)
#pragma unroll
            for (int m = 0; m < 4; ++m) { const int row = row0 + ai * HALF + m * 16; const float f = rsqrtf(ss[T + row] * (1.0f / 512) + EPS);
#pragma unroll
                for (int bj = 0; bj < 2; ++bj) *(u32x4*)(O + (size_t)row * 1024 + col0 + bj * HALF) = pack8(acc[ai][bj][m][0] * f, acc[ai][bj][m][1] * f); }
    }
};
}

template <class Epi> DI void run_gemm(LAS unsigned char* lds, const bf16_t* A, int lda, size_t sA, const bf16_t* Bt, int ldb, size_t sB, int M, int N, int K, int nB, const Epi& E, int crot = 0) {
    pg8::Gemm g; g.A = A; g.Bt = Bt; g.lda = lda; g.ldb = ldb; g.K = K; g.sA = sA; g.sB = sB;
    pg8::Order S; S.init(M, N, nB, (int)gridDim.x, (int)((blockIdx.x + crot) % gridDim.x));
    pg8::gemm_phase<Epi>(lds, g, S, E);
}

#define MFMA32(a, b, c) __builtin_amdgcn_mfma_f32_32x32x16_bf16((a), (b), (c), 0, 0, 0)
DI bf16x8 pack_p(const f32x16& x, int s) {
    u32x4 w; w.x = pk2(x[8 * s], x[8 * s + 1]); w.y = pk2(x[8 * s + 2], x[8 * s + 3]); w.z = pk2(x[8 * s + 4], x[8 * s + 5]); w.w = pk2(x[8 * s + 6], x[8 * s + 7]);
    return __builtin_bit_cast(bf16x8, w);
}
constexpr int KS_LD = 104, VS_LD = 68;
constexpr int KS_BYTES = 64 * KS_LD * 2, VS_BYTES = 64 * VS_LD * 2;
DI float xhalf_max(float v) { const auto r = __builtin_amdgcn_permlane32_swap(__float_as_uint(v), __float_as_uint(v), false, false); return fmaxf(__uint_as_float(r[0]), __uint_as_float(r[1])); }
DI float xhalf_sum(float v) { const auto r = __builtin_amdgcn_permlane32_swap(__float_as_uint(v), __float_as_uint(v), false, false); return __uint_as_float(r[0]) + __uint_as_float(r[1]); }
DI float max3f(float a, float b, float c) { return __builtin_fmaxf(__builtin_fmaxf(a, b), c); }
DI float max16(const f32x16& x) {
    const float a = max3f(x[0], x[1], x[2]), b = max3f(x[3], x[4], x[5]), c = max3f(x[6], x[7], x[8]), d = max3f(x[9], x[10], x[11]), e = max3f(x[12], x[13], x[14]);
    return max3f(max3f(a, b, c), d, max3f(e, x[15], x[15]));
}
DI void exp16(f32x16& x, float& sum) {
#pragma unroll
    for (int i = 0; i < 16; ++i) { x[i] = __builtin_amdgcn_exp2f(x[i]); sum += x[i]; }
}
constexpr float ATT_THRESH = 5.0f;
DI void attn_phase(const Params& p, unsigned char* smem) {
    const int tid = threadIdx.x, wid = tid >> 6, lane = tid & 63, r = lane & 31, hh = lane >> 5;
    const bf16_t* Qg = (const bf16_t*)(p.ws + O_Q); const bf16_t* Kg = (const bf16_t*)(p.ws + O_KN); const bf16_t* Vg = (const bf16_t*)(p.ws + O_VT); const bf16_t* Pg = (const bf16_t*)(p.ws + O_KPE);
    bf16_t* cat = (bf16_t*)(p.ws + O_H);
    const int G = gridDim.x; const int vb = (G & 7) ? (int)blockIdx.x : (int)((blockIdx.x & 7) * (G >> 3) + (blockIdx.x >> 3));
    for (int u = vb; u < 768; u += G) {
        int s, h, qt, L, tb;
        if (u < 512) { s = u >> 6; h = (u >> 3) & 7; qt = u & 7; L = LP; tb = s * LP; }
        else { const int v = u - 512; s = v >> 5; h = (v >> 2) & 7; qt = v & 3; L = LS; tb = TP + s * LS; }
        const bf16_t* Qb = Qg + ((size_t)tb * 8 + (size_t)h * L) * 96;
        const bf16_t* Kb = Kg + ((size_t)tb * 8 + (size_t)h * L) * 64;
        const bf16_t* Vb = Vg + (size_t)tb * 512 + (size_t)h * 64 * L;
        const bf16_t* Pb = Pg + (size_t)tb * 32;
        const int q = qt * 512 + wid * 64 + r;
        bf16x8 qa[6], qb[6];
#pragma unroll
        for (int s6 = 0; s6 < 6; ++s6) { qa[s6] = *(const bf16x8*)(Qb + (size_t)q * 96 + 16 * s6 + 8 * hh); qb[s6] = *(const bf16x8*)(Qb + (size_t)(q + 32) * 96 + 16 * s6 + 8 * hh); }
        f32x16 o0a, o1a, o0b, o1b;
#pragma unroll
        for (int i = 0; i < 16; ++i) { o0a[i] = 0.f; o1a[i] = 0.f; o0b[i] = 0.f; o1b[i] = 0.f; }
        float ma = 0.f, mb = 0.f, la = 0.f, lb = 0.f;
        asm volatile("" : "+v"(ma), "+v"(mb));
        const int nkt = L / 64;
#define ATT_OPAQUE_TID(t) int t = tid; asm volatile("" : "+v"(t))
        u32x4 kreg, vreg; u32x2 preg;
        auto load_tile = [&](int t) { ATT_OPAQUE_TID(t1); const int key = t1 >> 3, part = t1 & 7;
            kreg = *(const u32x4*)(Kb + (size_t)t * 4096 + (unsigned)(key * 64 + part * 8));
            preg = *(const u32x2*)(Pb + (size_t)t * 2048 + (unsigned)(key * 32 + part * 4));
            vreg = *(const u32x4*)(Vb + (size_t)t * 64 + (unsigned)(key * L + part * 8)); };
        auto write_tile = [&](int kbuf, int vbuf) { ATT_OPAQUE_TID(t4); const int key = t4 >> 3, part = t4 & 7;
            bf16_t* Kw = (bf16_t*)(smem + kbuf * KS_BYTES); bf16_t* Vw = (bf16_t*)(smem + 2 * KS_BYTES + vbuf * VS_BYTES);
            *(u32x4*)(Kw + key * KS_LD + part * 8) = kreg;
            *(u32x2*)(Kw + key * KS_LD + 64 + part * 4) = preg;
            *(u32x2*)(Vw + key * VS_LD + part * 8) = (u32x2){vreg.x, vreg.y}; *(u32x2*)(Vw + key * VS_LD + part * 8 + 4) = (u32x2){vreg.z, vreg.w}; };
        f32x16 s0a, s1a, s0b, s1b;
        auto s_stage = [&](int kbuf) {
            const bf16_t* Ks = (const bf16_t*)(smem + kbuf * KS_BYTES);
#pragma unroll
            for (int i = 0; i < 16; ++i) { s0a[i] = -ma; s1a[i] = -ma; s0b[i] = -mb; s1b[i] = -mb; }
            ATT_OPAQUE_TID(t2); const int r2 = t2 & 31, h2 = (t2 >> 5) & 1; const bf16_t* kp = Ks + r2 * KS_LD + 8 * h2;
            bf16x8 f0[2], f1[2];
            f0[0] = *(const bf16x8*)(kp); f1[0] = *(const bf16x8*)(kp + 32 * KS_LD);
            __builtin_amdgcn_sched_group_barrier(0x100, 2, 0);
#pragma unroll
            for (int s6 = 0; s6 < 6; ++s6) {
                if (s6 + 1 < 6) { f0[(s6 + 1) & 1] = *(const bf16x8*)(kp + 16 * (s6 + 1)); f1[(s6 + 1) & 1] = *(const bf16x8*)(kp + 32 * KS_LD + 16 * (s6 + 1)); }
                const bf16x8 a0 = f0[s6 & 1], a1 = f1[s6 & 1];
                s0a = MFMA32(a0, qa[s6], s0a); s0b = MFMA32(a0, qb[s6], s0b); s1a = MFMA32(a1, qa[s6], s1a); s1b = MFMA32(a1, qb[s6], s1b);
                if (s6 + 1 < 6) __builtin_amdgcn_sched_group_barrier(0x100, 2, 0);
                __builtin_amdgcn_sched_group_barrier(0x008, 4, 0);
            } };
        auto softmax_stage = [&](bool first) {
            float mxa = fmaxf(max16(s0a), max16(s1a)), mxb = fmaxf(max16(s0b), max16(s1b));
            mxa = xhalf_max(mxa); mxb = xhalf_max(mxb);
            if (first || __builtin_amdgcn_ballot_w64(fmaxf(mxa, mxb) > ATT_THRESH) != 0ull) {
                const float da = first ? mxa : fmaxf(mxa, 0.f), db = first ? mxb : fmaxf(mxb, 0.f);
                const float aa = __builtin_amdgcn_exp2f(-fabsf(da)), ab = __builtin_amdgcn_exp2f(-fabsf(db));
                ma += da; mb += db; la *= aa; lb *= ab;
#pragma unroll
                for (int i = 0; i < 16; ++i) { s0a[i] -= da; s1a[i] -= da; s0b[i] -= db; s1b[i] -= db; o0a[i] *= aa; o1a[i] *= aa; o0b[i] *= ab; o1b[i] *= ab; }
            }
            exp16(s0a, la); exp16(s1a, la); exp16(s0b, lb); exp16(s1b, lb); };
        auto pv_stage = [&](int vbuf) {
            const bf16_t* Vs = (const bf16_t*)(smem + 2 * KS_BYTES + vbuf * VS_BYTES);
            ATT_OPAQUE_TID(t3); const int r3 = t3 & 31, h3 = (t3 >> 5) & 1; const bf16_t* vp = Vs + r3 * VS_LD + 4 * h3;
            bf16x8 g0[2], g1[2];
            { const s16x4 lo0 = *(const s16x4*)vp, hi0 = *(const s16x4*)(vp + 8), lo1 = *(const s16x4*)(vp + 32 * VS_LD), hi1 = *(const s16x4*)(vp + 32 * VS_LD + 8);
              g0[0] = __builtin_shufflevector(lo0, hi0, 0, 1, 2, 3, 4, 5, 6, 7); g1[0] = __builtin_shufflevector(lo1, hi1, 0, 1, 2, 3, 4, 5, 6, 7); }
            __builtin_amdgcn_sched_group_barrier(0x100, 2, 0);
#pragma unroll
            for (int st = 0; st < 4; ++st) {
                if (st + 1 < 4) { const bf16_t* v0p = vp + 16 * (st + 1); const bf16_t* v1p = v0p + 32 * VS_LD;
                    const s16x4 lo0 = *(const s16x4*)v0p, hi0 = *(const s16x4*)(v0p + 8), lo1 = *(const s16x4*)v1p, hi1 = *(const s16x4*)(v1p + 8);
                    g0[(st + 1) & 1] = __builtin_shufflevector(lo0, hi0, 0, 1, 2, 3, 4, 5, 6, 7); g1[(st + 1) & 1] = __builtin_shufflevector(lo1, hi1, 0, 1, 2, 3, 4, 5, 6, 7); }
                const bf16x8 pa = pack_p((st >> 1) ? s1a : s0a, st & 1), pb = pack_p((st >> 1) ? s1b : s0b, st & 1);
                const bf16x8 vf0 = g0[st & 1], vf1 = g1[st & 1];
                o0a = MFMA32(vf0, pa, o0a); o0b = MFMA32(vf0, pb, o0b); o1a = MFMA32(vf1, pa, o1a); o1b = MFMA32(vf1, pb, o1b);
            } };
        load_tile(0); write_tile(0, 0);
        __syncthreads();
        if (wid < 4) {
            int vcur = 0;
            for (int kt = 0; kt < nkt; ++kt) {
                const int vnext = vcur == 2 ? 0 : vcur + 1;
                if (kt + 1 < nkt) load_tile(kt + 1);
                s_stage(kt & 1);
                softmax_stage(kt == 0); pv_stage(vcur);
                if (kt + 1 < nkt) write_tile((kt + 1) & 1, vnext);
                vcur = vnext;
                __syncthreads();
            }
        } else {
            int vcur = 0, vprev = 0;
            for (int kt = 0; kt < nkt; ++kt) {
                const int vnext = vcur == 2 ? 0 : vcur + 1;
                if (kt + 1 < nkt) load_tile(kt + 1);
                if (kt > 0) { softmax_stage(kt == 1); pv_stage(vprev); }
                s_stage(kt & 1);

                if (kt + 1 < nkt) write_tile((kt + 1) & 1, vnext);
                vprev = vcur; vcur = vnext;
                __syncthreads();
            }
            softmax_stage(nkt == 1); pv_stage(vprev);
        }
        const float ia = 1.0f / xhalf_sum(la), ib = 1.0f / xhalf_sum(lb);
        { float qa2 = 0.f, qb2 = 0.f;
#pragma unroll
          for (int i = 0; i < 16; ++i) { qa2 += o0a[i] * o0a[i] + o1a[i] * o1a[i]; qb2 += o0b[i] * o0b[i] + o1b[i] * o1b[i]; }
          qa2 *= ia * ia; qb2 *= ib * ib; qa2 = xhalf_sum(qa2); qb2 = xhalf_sum(qb2);
          float* sso = (float*)(p.ws + O_SS) + T;
          if (hh == 0) { atomicAdd(sso + tb + q, qa2); atomicAdd(sso + tb + q + 32, qb2); } }
        bf16_t* orow = cat + (size_t)(tb + q) * 1024 + 512 + h * 64 + 4 * hh;
#pragma unroll
        for (int g4 = 0; g4 < 4; ++g4) {
            *(u32x2*)(orow + 8 * g4) = (u32x2){pk2(o0a[4 * g4] * ia, o0a[4 * g4 + 1] * ia), pk2(o0a[4 * g4 + 2] * ia, o0a[4 * g4 + 3] * ia)};
            *(u32x2*)(orow + 32 + 8 * g4) = (u32x2){pk2(o1a[4 * g4] * ia, o1a[4 * g4 + 1] * ia), pk2(o1a[4 * g4 + 2] * ia, o1a[4 * g4 + 3] * ia)};
            *(u32x2*)(orow + 32 * 1024 + 8 * g4) = (u32x2){pk2(o0b[4 * g4] * ib, o0b[4 * g4 + 1] * ib), pk2(o0b[4 * g4 + 2] * ib, o0b[4 * g4 + 3] * ib)};
            *(u32x2*)(orow + 32 * 1024 + 32 + 8 * g4) = (u32x2){pk2(o1b[4 * g4] * ib, o1b[4 * g4 + 1] * ib), pk2(o1b[4 * g4 + 2] * ib, o1b[4 * g4 + 3] * ib)};
        }
        __syncthreads();
    }
}

#define XB_TMO      128
#define XB_XCNT(j)  (256  + 64 * (j))
#define XB_XSUB(j)  (1280 + 64 * (j))
#define XB_XGEN(j)  (2304 + 64 * (j))
#define XB_TOP      3328
#define XB_TOPGEN   3392
#define XCD_BAR_WORDS 3456
#define XB_SPIN_CAP (1u << 22)
DI unsigned xb_ld(unsigned* p)              { return __hip_atomic_load(p, __ATOMIC_RELAXED, __HIP_MEMORY_SCOPE_AGENT); }
DI unsigned xb_add(unsigned* p, unsigned v) { return __hip_atomic_fetch_add(p, v, __ATOMIC_RELAXED, __HIP_MEMORY_SCOPE_AGENT); }
DI unsigned xb_xcc_id() { return (unsigned)__builtin_amdgcn_s_getreg((3 << 11) | 20) & 0xFu; }
#define XB_SPIN(cond, bar) do { unsigned _sp = 0; while (cond) { __builtin_amdgcn_s_sleep(1); \
    if ((++_sp & 255u) == 0u) { if (xb_ld(&(bar)[XB_TMO])) break; if (_sp > XB_SPIN_CAP) { atomicAdd(&(bar)[XB_TMO], 1u); break; } } } } while (0)
struct XcdBarrier { unsigned* bar; unsigned x; volatile LAS unsigned* st; };
DI XcdBarrier xcd_barrier_post(unsigned* bar, volatile LAS unsigned* st) {
    XcdBarrier b; b.bar = bar; b.x = xb_xcc_id(); b.st = st;
    if (threadIdx.x == 0) (void)xb_add(&bar[XB_XCNT(b.x)], 1u);
    return b;
}
DI void xcd_barrier_complete(unsigned* bar, unsigned x, unsigned& nloc, unsigned& nx) {
    const unsigned G = gridDim.x * gridDim.y * gridDim.z;
    unsigned sum, cnt, mine, sp = 0u;
    for (;;) {
        sum = 0u; cnt = 0u; mine = 0u;
#pragma unroll
        for (unsigned j = 0; j < 16; ++j) { const unsigned c = xb_ld(&bar[XB_XCNT(j)]); sum += c; cnt += (c > 0u) ? 1u : 0u; mine = (j == x) ? c : mine; }
        if (sum == G) break;
        __builtin_amdgcn_s_sleep(1);
        if ((++sp & 255u) == 0u) { if (xb_ld(&bar[XB_TMO])) break; if (sp > XB_SPIN_CAP) { atomicAdd(&bar[XB_TMO], 1u); break; } }
    }
    nloc = mine > 0u ? mine : 1u; nx = cnt > 0u ? cnt : 1u;
}
DI void xcd_barrier(const XcdBarrier& b) {
    asm volatile("s_waitcnt vmcnt(0)" ::: "memory");
    __syncthreads();
    if (threadIdx.x == 0) {
        unsigned* bar = b.bar;
        __builtin_amdgcn_s_waitcnt(0);
        unsigned nloc = b.st[0], nx = b.st[1];
        if (nloc == 0u) { xcd_barrier_complete(bar, b.x, nloc, nx); b.st[0] = nloc; b.st[1] = nx; }
        const unsigned old = xb_add(&bar[XB_XSUB(b.x)], 1u);
        const unsigned gen = old / nloc;
        if (old + 1u == (gen + 1u) * nloc) {
            __builtin_amdgcn_fence(__ATOMIC_RELEASE, "agent");
            asm volatile("s_waitcnt vmcnt(0)" ::: "memory");
            const unsigned og = xb_add(&bar[XB_TOP], 1u);
            const unsigned tg = og / nx;
            if (og + 1u == (tg + 1u) * nx) xb_add(&bar[XB_TOPGEN], 1u);
            else XB_SPIN(xb_ld(&bar[XB_TOPGEN]) == tg, bar);
            __builtin_amdgcn_fence(__ATOMIC_ACQUIRE, "agent");
            xb_add(&bar[XB_XGEN(b.x)], 1u);
            asm volatile("s_waitcnt vmcnt(0)" ::: "memory");
        } else {
            XB_SPIN(xb_ld(&bar[XB_XGEN(b.x)]) == gen, bar);
            __builtin_amdgcn_fence(__ATOMIC_ACQUIRE, "agent");
            asm volatile("s_waitcnt vmcnt(0)" ::: "memory");
        }
    }
    __syncthreads();
}

constexpr int NPHASE = 15;
#define PROBE_ATTN 0
#define PROBE_P1 0
#define PROBE_P0 0
#define PROBE_R2 0
#define PROBE_P56 0
#define PROBE_SYNC 0
#ifndef ONLY_PHASE
#define ONLY_PHASE -1
#endif
#define PH_ON(n) (ONLY_PHASE < 0 || ONLY_PHASE == (n))
__global__ void __launch_bounds__(512, 2) mega(Params p, int lo, int hi) {
    extern __shared__ __attribute__((aligned(16))) unsigned char shm[];
    cg::grid_group grid = cg::this_grid();
    LAS unsigned char* lds = (LAS unsigned char*)shm;
    unsigned char* ws = p.ws;
    bf16_t* H = (bf16_t*)(ws + O_H);
    volatile LAS unsigned* xst = (volatile LAS unsigned*)(shm + 131072);
    if (threadIdx.x == 0) { xst[0] = 0u; xst[1] = 0u; xst[2] = 0u; xst[3] = 0u; }
    __syncthreads();
    const XcdBarrier xb = xcd_barrier_post((unsigned*)(ws + O_BAR), xst);
    if (PH_ON(0) && lo <= 0 && 0 < hi) {
            float* tile = (float*)shm;
#if PROBE_P0
            int rep0 = -1; again0: ++rep0;
#endif
            conv_T<1>(p.in[3], 1024, DFF, (bf16_t*)(ws + O_WGU1), tile);
            conv_T<2>(p.in[4], 1024, DFF, (bf16_t*)(ws + O_WGU1), tile);
            conv_T<0>(p.in[5], DFF, 1024, (bf16_t*)(ws + O_WD1), tile);
            conv_T<4>(p.in[8], 1024, DIN, (bf16_t*)(ws + O_WIN), tile);
            conv_T<3>(p.in[28], 384, 768, (bf16_t*)(ws + O_WUQ), tile, p.in[27], p.in[27], 384);
            conv_T<0>(p.in[30], 256, 1024, (bf16_t*)(ws + O_WUKV), tile, p.in[29], p.in[29], 256);
            conv_T<0>(p.in[24], 512, 512, (bf16_t*)(ws + O_WGLU), tile);
            conv_T<0>(p.in[32], 1024, 1024, (bf16_t*)(ws + O_WOUT), tile, p.in[26], p.in[31], 512);
            { bf16_t* wp = (bf16_t*)(ws + O_WIN) + (size_t)DIN * 1024; for (int i = blockIdx.x * blockDim.x + threadIdx.x; i < (DINP - DIN) * 1024; i += gridDim.x * blockDim.x) wp[i] = 0; }
            { float* ssz = (float*)(ws + O_SS); for (int i = blockIdx.x * blockDim.x + threadIdx.x; i < 4 * T; i += gridDim.x * blockDim.x) ssz[i] = 0.f; }
            tables_phase0(p);
            rowpass_first(p);
#if PROBE_P0
            if (rep0 == 0) { __syncthreads(); goto again0; }
#endif
    }
    if (lo <= 0 && 1 < hi) xcd_barrier(xb);
    if (PH_ON(1) && lo <= 1 && 1 < hi) {
            ktab_phase(p);
            pg8::EpiSwiGLU E; E.O = (bf16_t*)(ws + O_A);
            run_gemm(lds, H, 1024, 0, (const bf16_t*)(ws + O_WGU1), 1024, 0, T, 5632, 1024, 1, E);
#if PROBE_P1
            run_gemm(lds, H, 1024, 0, (const bf16_t*)(ws + O_WGU1), 1024, 0, T, 5632, 1024, 1, E);
#endif
    }
    if (lo <= 1 && 2 < hi) xcd_barrier(xb);
    if (PH_ON(2) && lo <= 2 && 2 < hi) {
            pg8::EpiBf16 E; E.O = H; E.ldc = 1024;
            run_gemm(lds, (const bf16_t*)(ws + O_A), DFF, 0, (const bf16_t*)(ws + O_WD1), DFF, 0, T, 1024, DFF, 1, E);
    }
    if (lo <= 2 && 3 < hi) xcd_barrier(xb);
    if (PH_ON(3) && lo <= 3 && 3 < hi) {
                        rowpass_res<0>(p, H, 0.5f, p.in[6], p.in[7], H);
            expand_phase(p);
    }
    if (lo <= 3 && 4 < hi) xcd_barrier(xb);
    if (PH_ON(4) && lo <= 4 && 4 < hi) {
            pg8::EpiZ E; E.UA = (bf16_t*)(ws + O_UA); E.zq = (bf16_t*)(ws + O_ZQ); E.kpe = (bf16_t*)(ws + O_KPE); E.ssq = (float*)(ws + O_SSQ); E.rope = (const f32x2*)(ws + O_ROPE);
            run_gemm(lds, H, 1024, 0, (const bf16_t*)(ws + O_WIN), 1024, 0, T, DINP, 1024, 1, E);
    }
    if (lo <= 4 && 5 < hi) xcd_barrier(xb);
    if (PH_ON(5) && lo <= 5 && 5 < hi) {
            { pg8::EpiF32 E; E.C = (float*)(ws + O_S); E.ldc = 256; E.sC = (size_t)NCH * 256;
              run_gemm(lds, (const bf16_t*)(ws + O_UA), 768, (size_t)NCH * 768, (const bf16_t*)(ws + O_BS), 512, (size_t)256 * 512, NCH, 256, 512, 32, E); }
            asm volatile("s_waitcnt vmcnt(0)" ::: "memory"); __syncthreads(); __threadfence();
            for (int L = blockIdx.x; L < 32 * 6; L += gridDim.x) scan_unit(p, L / 6, L % 6);
            __syncthreads();
#ifndef NO_P6A
            { pg8::EpiQ E; E.Q = (bf16_t*)(ws + O_Q); E.rope = (const f32x2*)(ws + O_ROPE); E.qs = 0.10206207261596577f * 1.4426950408889634f; E.ssq = (const float*)(ws + O_SSQ);
              run_gemm(lds, (const bf16_t*)(ws + O_ZQ), 640, 0, (const bf16_t*)(ws + O_WUQ), 384, 0, T, 768, 384, 1, E, (int)(gridDim.x >> 2)); }
#endif
#ifndef NO_P6B
            { pg8::EpiKV E; E.Kn = (bf16_t*)(ws + O_KN); E.Vt = (bf16_t*)(ws + O_VT); E.sskv = (const float*)(ws + O_SSQ) + T;
              run_gemm(lds, (const bf16_t*)(ws + O_ZQ) + 384, 640, 0, (const bf16_t*)(ws + O_WUKV), 256, 0, T, 1024, 256, 1, E); }
#endif
    }
    if (lo <= 5 && 6 < hi) xcd_barrier(xb);
    if (PH_ON(7) && lo <= 7 && 7 < hi) {
            { pg8::EpiY E; E.yg = (bf16_t*)(ws + O_YG);
              run_gemm(lds, (const bf16_t*)(ws + O_UA), 768, (size_t)NCH * 768, (const bf16_t*)(ws + O_MY), 768, (size_t)512 * 768, NCH, 512, 768, 32, E); }
            if (threadIdx.x >= 256) __builtin_amdgcn_s_setprio(1);
            attn_phase(p, shm);
            __builtin_amdgcn_s_setprio(0);
#if PROBE_ATTN
            __syncthreads(); attn_phase(p, shm);
#endif
    }
    if (lo <= 7 && 8 < hi) xcd_barrier(xb);
    if (PH_ON(8) && lo <= 8 && 8 < hi) {
            { float* tile = (float*)shm;
              conv_T<1>(p.in[35], 1024, DFF, (bf16_t*)(ws + O_WGU2), tile);
              conv_T<2>(p.in[36], 1024, DFF, (bf16_t*)(ws + O_WGU2), tile);
              conv_T<0>(p.in[37], DFF, 1024, (bf16_t*)(ws + O_WD2), tile);
              __syncthreads(); }
            pg8::EpiGLU E; E.yg = (const bf16_t*)(ws + O_YG); E.bias = p.in[25]; E.cat = H; E.ss = (float*)(ws + O_SS);
            run_gemm(lds, (const bf16_t*)(ws + O_YG), 512, 0, (const bf16_t*)(ws + O_WGLU), 512, 0, T, 512, 512, 1, E);
    }
    if (lo <= 8 && 9 < hi) xcd_barrier(xb);
    if (PH_ON(9) && lo <= 9 && 9 < hi) {
    }
    if (PH_ON(10) && lo <= 10 && 10 < hi) {
            pg8::EpiOut E; E.O = (bf16_t*)(ws + O_M2); E.ss = (const float*)(ws + O_SS);
            run_gemm(lds, H, 1024, 0, (const bf16_t*)(ws + O_WOUT), 1024, 0, T, 1024, 1024, 1, E);
    }
    if (lo <= 10 && 11 < hi) xcd_barrier(xb);
    if (PH_ON(11) && lo <= 11 && 11 < hi) {
            rowpass_res<1>(p, (const bf16_t*)(ws + O_M2), 1.0f, p.in[33], p.in[34], H);
    }
    if (lo <= 11 && 12 < hi) xcd_barrier(xb);
    if (PH_ON(12) && lo <= 12 && 12 < hi) {
            pg8::EpiSwiGLU E; E.O = (bf16_t*)(ws + O_A2);
            run_gemm(lds, H, 1024, 0, (const bf16_t*)(ws + O_WGU2), 1024, 0, T, 5632, 1024, 1, E);
    }
    if (lo <= 12 && 13 < hi) xcd_barrier(xb);
    if (PH_ON(13) && lo <= 13 && 13 < hi) {
            pg8::EpiBf16 E; E.O = H; E.ldc = 1024;
            run_gemm(lds, (const bf16_t*)(ws + O_A2), DFF, 0, (const bf16_t*)(ws + O_WD2), DFF, 0, T, 1024, DFF, 1, E);
    }
    if (lo <= 13 && 14 < hi) xcd_barrier(xb);
    if (PH_ON(14) && lo <= 14 && 14 < hi) {
            rowpass_res<2>(p, H, 0.5f, p.in[38], nullptr, H);
    }
    if (hi > NPHASE) grid.sync();
}

extern "C" void kernel_launch(void* const* d_in, const int* in_sizes, int n_in, void* d_out, int out_size, void* d_ws, size_t ws_size, hipStream_t stream) {
    constexpr size_t kDynLds = 131072 + 16;
    static int grid_blocks = 0;
    if (!grid_blocks) {
        int dev = 0, cus = 0, per_cu = 0;
        hipGetDevice(&dev);
        hipDeviceGetAttribute(&cus, hipDeviceAttributeMultiprocessorCount, dev);
        hipFuncSetAttribute((const void*)mega, hipFuncAttributeMaxDynamicSharedMemorySize, (int)kDynLds);
        hipOccupancyMaxActiveBlocksPerMultiprocessor(&per_cu, mega, 512, kDynLds);
        if (per_cu < 1) per_cu = 1;
        if (per_cu > 1) per_cu = 1;
        grid_blocks = cus * per_cu;
    }
    if (ws_size < O_TOTAL || n_in < 39) { fprintf(stderr, "workspace too small: %zu < %zu\n", ws_size, (size_t)O_TOTAL); return; }
    Params p{};
    for (int i = 0; i < 39; ++i) p.in[i] = (const float*)d_in[i];
    p.out = (float*)d_out; p.ws = (unsigned char*)d_ws;
    int lo = 0, hi = NPHASE;
    hipMemsetAsync((unsigned char*)d_ws + O_BAR, 0, 16384, stream);
    void* args[] = {&p, &lo, &hi};
    hipError_t e = hipLaunchCooperativeKernel((const void*)mega, dim3(grid_blocks), dim3(512), args, kDynLds, stream);
    if (e != hipSuccess) fprintf(stderr, "cooperative launch failed: %s (grid %d)\n", hipGetErrorString(e), grid_blocks);
}
```

```cpp
#include <hip/hip_runtime.h>
#include <hip/hip_cooperative_groups.h>
#include <cstdio>
namespace cg = cooperative_groups;

#define DI __device__ __forceinline__
#define LAS __attribute__((address_space(3)))
typedef unsigned short bf16_t;
typedef short bf16x8 __attribute__((ext_vector_type(8)));
typedef short s16x4 __attribute__((ext_vector_type(4)));
typedef float f32x2 __attribute__((ext_vector_type(2)));
typedef float f32x4 __attribute__((ext_vector_type(4)));
typedef float f32x16 __attribute__((ext_vector_type(16)));
typedef unsigned u32x2 __attribute__((ext_vector_type(2)));
typedef unsigned u32x4 __attribute__((ext_vector_type(4)));
typedef __bf16 bf16x2_t __attribute__((ext_vector_type(2)));

constexpr int T = 49152, TP = 32768, LP = 4096, LS = 2048, D = 1024, DFF = 2816, DIN = 1184, DINP = 1280;
constexpr int LC = 32, NCH = T / LC;
constexpr float EPS = 1e-6f;

constexpr size_t SZ_WGU = (size_t)5632 * 1024 * 2, SZ_WD = (size_t)1024 * 2816 * 2;
constexpr size_t O_WGU1 = 0;
constexpr size_t O_WD1 = O_WGU1 + SZ_WGU;
constexpr size_t O_WIN = O_WD1 + SZ_WD;
constexpr size_t O_WUQ = O_WIN + (size_t)DINP * 1024 * 2;
constexpr size_t O_WUKV = O_WUQ + (size_t)768 * 384 * 2;
constexpr size_t O_WGLU = O_WUKV + (size_t)1024 * 256 * 2;
constexpr size_t O_WOUT = O_WGLU + (size_t)512 * 512 * 2;
constexpr size_t O_BS = O_WOUT + (size_t)1024 * 1024 * 2;
constexpr size_t O_MY = O_BS + (size_t)32 * 256 * 512 * 2;
constexpr size_t O_ROPE = O_MY + (size_t)32 * 512 * 768 * 2;
constexpr size_t O_LBP = O_ROPE + (size_t)4096 * 16 * 8;
constexpr size_t O_BB = O_LBP + (size_t)32 * 2 * 33 * 64 * 8;
constexpr size_t O_KTAB = O_BB + (size_t)32 * 2 * 64 * 16 * 8;
constexpr size_t O_H = O_KTAB + (size_t)32 * 2 * 32 * 256 * 4;
constexpr size_t O_R = O_H + (size_t)T * 1024 * 2;
constexpr size_t O_UA = O_R;
constexpr size_t O_WGU2 = O_R;
constexpr size_t O_WD2 = O_WGU2 + SZ_WGU;
constexpr size_t O_ZQ = O_UA + (size_t)32 * NCH * 768 * 2;
constexpr size_t O_S = O_ZQ + (size_t)T * 640 * 2;
constexpr size_t O_YG = O_S;
constexpr size_t O_Q = O_S + (size_t)32 * NCH * 256 * 4;
constexpr size_t O_KPE = O_Q + (size_t)T * 768 * 2;
constexpr size_t O_KN = O_KPE + (size_t)T * 32 * 2;
constexpr size_t O_VT = O_KN + (size_t)T * 512 * 2;
constexpr size_t O_END = O_VT + (size_t)T * 512 * 2;
constexpr size_t O_BAR = O_END;
constexpr size_t O_SS = O_BAR + 16384;
constexpr size_t O_SSQ = O_SS + (size_t)2 * T * 4;
constexpr size_t O_TOTAL = O_SSQ + (size_t)2 * T * 4;
constexpr size_t O_A = O_ZQ;
constexpr size_t O_M2 = O_ZQ;
constexpr size_t O_A2 = O_WD2 + SZ_WD;
constexpr size_t O_X2A = O_A2 + (size_t)T * DFF * 2;
constexpr int X2_ROWS_A = (int)((O_END - O_X2A) / 2048);
constexpr size_t O_X2B = O_BS;
static_assert(O_X2A < O_END && X2_ROWS_A > 0 && X2_ROWS_A < T, "x2 split");
static_assert(O_X2B + (size_t)(T - X2_ROWS_A) * 2048 <= O_H, "x2 tail fits in the SSM area");
static_assert(O_A + (size_t)T * DFF * 2 <= O_END, "ffn hidden fits");
static_assert(O_M2 + (size_t)T * 1024 * 4 <= O_END, "m2 fits");
static_assert(O_WD2 + SZ_WD <= O_ZQ, "ffn2 weights fit in UA area");

struct Params { const float* in[39]; float* out; unsigned char* ws; };

DI unsigned pk2(float a, float b) { f32x2 v = {a, b}; bf16x2_t r = __builtin_convertvector(v, bf16x2_t); return __builtin_bit_cast(unsigned, r); }
DI bf16_t f2bf(float a) { return (bf16_t)(pk2(a, 0.f) & 0xffffu); }
DI float bflo(unsigned u) { return __uint_as_float(u << 16); }
DI float bfhi(unsigned u) { return __uint_as_float(u & 0xffff0000u); }
DI float bf2f(bf16_t b) { return __uint_as_float(((unsigned)b) << 16); }
DI f32x4 ld_nt(const float* p) { return __builtin_nontemporal_load((const f32x4*)p); }
DI u32x2 ld_nt2(const bf16_t* p) { return __builtin_nontemporal_load((const u32x2*)p); }
DI void st_nt(float* p, f32x4 v) { __builtin_nontemporal_store(v, (f32x4*)p); }
DI void st_nt2(bf16_t* p, u32x2 v) { __builtin_nontemporal_store(v, (u32x2*)p); }
DI float wave_sum(float v) {
#pragma unroll
    for (int o = 32; o >= 1; o >>= 1) v += __shfl_xor(v, o);
    return v;
}
DI float fast_rcp(float x) { return __builtin_amdgcn_rcpf(x); }
DI float fast_exp(float x) { return __builtin_amdgcn_exp2f(x * 1.4426950408889634f); }
DI float sigmoidf_(float x) { return fast_rcp(1.0f + fast_exp(-x)); }
DI float siluf_(float x) { return x * sigmoidf_(x); }
DI float gelu_tanh(float x) { const float z = 0.7978845608028654f * (x + 0.044715f * x * x * x); return x * sigmoidf_(2.0f * z); }
DI void tokinfo(int row, int& tb, int& L, int& pos) {
    if (row < TP) { tb = row & ~(LP - 1); L = LP; pos = row & (LP - 1); }
    else { const int r = row - TP; tb = TP + (r & ~(LS - 1)); L = LS; pos = r & (LS - 1); }
}
DI double exp_d(double x) {
    const double y = x * (1.0 / 64.0);
    double p = 1.0 + y * (1.0 + y * 0.5 * (1.0 + y * (1.0 / 3) * (1.0 + y * 0.25 * (1.0 + y * 0.2 * (1.0 + y * (1.0 / 6) * (1.0 + y * (1.0 / 7) * (1.0 + y * 0.125 * (1.0 + y * (1.0 / 9) * (1.0 + y * 0.1)))))))));
#pragma unroll
    for (int i = 0; i < 6; ++i) p *= p;
    return p;
}
DI void sincos_d(double ang, double& s, double& c) {
    double t = ang * 0.15915494309189535; t -= rint(t);
    const double r = t * (6.283185307179586 * 0.125), r2 = r * r;
    s = r * (1.0 - r2 * (1.0 / 6) * (1.0 - r2 * (1.0 / 20) * (1.0 - r2 * (1.0 / 42) * (1.0 - r2 * (1.0 / 72) * (1.0 - r2 * (1.0 / 110))))));
    c = 1.0 - r2 * 0.5 * (1.0 - r2 * (1.0 / 12) * (1.0 - r2 * (1.0 / 30) * (1.0 - r2 * (1.0 / 56) * (1.0 - r2 * (1.0 / 90)))));
#pragma unroll
    for (int i = 0; i < 3; ++i) { const double s2 = 2.0 * s * c, c2 = 1.0 - 2.0 * s * s; s = s2; c = c2; }
}

template <int MODE> DI int rowmap(int n) {
    if (MODE == 1) return ((n >> 7) << 8) + (n & 127);
    if (MODE == 2) return ((n >> 7) << 8) + 128 + (n & 127);
    if (MODE == 3) { const int h = n / 96, d = n - h * 96; const int dd = d < 64 ? d : (d < 80 ? 64 + 2 * (d - 64) : 65 + 2 * (d - 80)); return h * 96 + dd; }
    if (MODE == 4) return n < 1152 ? n : (n < 1168 ? 1152 + 2 * (n - 1152) : 1153 + 2 * (n - 1168));
    return n;
}
template <int MODE> DI void conv_T(const float* __restrict__ W, int K, int N, bf16_t* __restrict__ Wt, float* tile, const float* ga = nullptr, const float* gb = nullptr, int ksplit = 0) {
    const int tid = threadIdx.x, nkt = K / 64, nnt = (N + 63) / 64, ntl = nkt * nnt;
    auto ldtile = [&](int t, f32x4 (&v)[2]) { const int kt = t % nkt, ntile = t / nkt, k0 = kt * 64, n0 = ntile * 64;
#pragma unroll
        for (int r = 0; r < 2; ++r) { const int kl = (tid >> 4) + 32 * r, n = n0 + (tid & 15) * 4;
            v[r] = n < N ? ld_nt(W + (size_t)(k0 + kl) * N + n) : (f32x4){0.f, 0.f, 0.f, 0.f};
            if (ga) { const int k = k0 + kl; v[r] *= (k < ksplit ? ga[k] : gb[k - ksplit]); } } };
    f32x4 cur[2], nxt[2];
    int t = blockIdx.x;
    if (t < ntl) ldtile(t, cur);
    for (; t < ntl; t += gridDim.x) {
        const int kt = t % nkt, ntile = t / nkt, k0 = kt * 64, n0 = ntile * 64;
        const bool more = t + (int)gridDim.x < ntl;
        if (more) ldtile(t + gridDim.x, nxt);
        __syncthreads();
#pragma unroll
        for (int r = 0; r < 2; ++r) { const int kl = (tid >> 4) + 32 * r, nl = (tid & 15) * 4;
            tile[kl * 65 + nl] = cur[r][0]; tile[kl * 65 + nl + 1] = cur[r][1]; tile[kl * 65 + nl + 2] = cur[r][2]; tile[kl * 65 + nl + 3] = cur[r][3]; }
        __syncthreads();
#pragma unroll
        for (int r = 0; r < 2; ++r) { const int nl = (tid >> 4) + 32 * r, kq = (tid & 15) * 4, n = n0 + nl;
            if (n < N) { u32x2 o; o.x = pk2(tile[kq * 65 + nl], tile[(kq + 1) * 65 + nl]); o.y = pk2(tile[(kq + 2) * 65 + nl], tile[(kq + 3) * 65 + nl]);
                *(u32x2*)(Wt + (size_t)rowmap<MODE>(n) * K + k0 + kq) = o; } }
        if (more) { cur[0] = nxt[0]; cur[1] = nxt[1]; }
    }
}

constexpr int NR = 4;
DI void rowpass_first(const Params& p) {
    const int wid = threadIdx.x >> 6, lane = threadIdx.x & 63, stride = gridDim.x * 8;
    bf16_t* h = (bf16_t*)(p.ws + O_H);
    const float* g = p.in[2];
    for (int row0 = blockIdx.x * 8 + wid; row0 < T; row0 += NR * stride) {
        f32x4 v[NR][4]; float ss[NR];
#pragma unroll
        for (int r = 0; r < NR; ++r) { const int row = row0 + r * stride; ss[r] = 0.f;
            if (row < T) { const float* xr = row < TP ? p.in[0] + (size_t)row * D : p.in[1] + (size_t)(row - TP) * D;
#pragma unroll
                for (int i = 0; i < 4; ++i) v[r][i] = ld_nt(xr + (lane + 64 * i) * 4); } }
#pragma unroll
        for (int r = 0; r < NR; ++r) { const int row = row0 + r * stride;
            if (row < T) {
#pragma unroll
                for (int i = 0; i < 4; ++i) ss[r] += v[r][i][0] * v[r][i][0] + v[r][i][1] * v[r][i][1] + v[r][i][2] * v[r][i][2] + v[r][i][3] * v[r][i][3];
                ss[r] = wave_sum(ss[r]);
                const float rstd = rsqrtf(ss[r] * (1.0f / D) + EPS);
#pragma unroll
                for (int i = 0; i < 4; ++i) { const f32x4 gg = *(const f32x4*)(g + (lane + 64 * i) * 4);
                    u32x2 o; o.x = pk2(v[r][i][0] * rstd * gg[0], v[r][i][1] * rstd * gg[1]); o.y = pk2(v[r][i][2] * rstd * gg[2], v[r][i][3] * rstd * gg[3]);
                    *(u32x2*)(h + (size_t)row * D + (lane + 64 * i) * 4) = o; } } }
    }
}
DI bf16_t* x2_row(unsigned char* ws, int row) { return row < X2_ROWS_A ? (bf16_t*)(ws + O_X2A) + (size_t)row * D : (bf16_t*)(ws + O_X2B) + (size_t)(row - X2_ROWS_A) * D; }
template <int STAGE> DI void rowpass_res(const Params& p, const bf16_t* msrc, float alpha, const float* gpost, const float* gnext, bf16_t* h) {
    const int wid = threadIdx.x >> 6, lane = threadIdx.x & 63, stride = gridDim.x * 8;
    for (int row0 = blockIdx.x * 8 + wid; row0 < T; row0 += NR * stride) {
        f32x4 m[NR][4], x[NR][4];
#pragma unroll
        for (int r = 0; r < NR; ++r) { const int row = row0 + r * stride;
            if (row < T) {
#pragma unroll
                for (int i = 0; i < 4; ++i) { const u32x2 u = ld_nt2(msrc + (size_t)row * D + (lane + 64 * i) * 4); m[r][i][0] = bflo(u.x); m[r][i][1] = bfhi(u.x); m[r][i][2] = bflo(u.y); m[r][i][3] = bfhi(u.y); }
#pragma unroll
                for (int i = 0; i < 4; ++i) {
                    if (STAGE == 0) { const float* xr = row < TP ? p.in[0] + (size_t)row * D : p.in[1] + (size_t)(row - TP) * D; x[r][i] = ld_nt(xr + (lane + 64 * i) * 4); }
                    else { const bf16_t* xr = STAGE == 1 ? (const bf16_t*)p.out + (size_t)row * D : x2_row(p.ws, row);
                        const u32x2 u = ld_nt2(xr + (lane + 64 * i) * 4); x[r][i][0] = bflo(u.x); x[r][i][1] = bfhi(u.x); x[r][i][2] = bflo(u.y); x[r][i][3] = bfhi(u.y); } } } }
#pragma unroll
        for (int r = 0; r < NR; ++r) { const int row = row0 + r * stride;
            if (row < T) {
                float ss = 0.f;
#pragma unroll
                for (int i = 0; i < 4; ++i) ss += m[r][i][0] * m[r][i][0] + m[r][i][1] * m[r][i][1] + m[r][i][2] * m[r][i][2] + m[r][i][3] * m[r][i][3];
                ss = wave_sum(ss);
                const float rstd = rsqrtf(ss * (1.0f / D) + EPS) * alpha;
                float s2 = 0.f;
#pragma unroll
                for (int i = 0; i < 4; ++i) {
                    const f32x4 gg = *(const f32x4*)(gpost + (lane + 64 * i) * 4);
                    m[r][i] = x[r][i] + m[r][i] * rstd * gg; s2 += m[r][i][0] * m[r][i][0] + m[r][i][1] * m[r][i][1] + m[r][i][2] * m[r][i][2] + m[r][i][3] * m[r][i][3];
                    if (STAGE == 2) st_nt(p.out + (size_t)row * D + (lane + 64 * i) * 4, m[r][i]);
                    else { bf16_t* xo = STAGE == 0 ? (bf16_t*)p.out + (size_t)row * D : x2_row(p.ws, row);
                        u32x2 o; o.x = pk2(m[r][i][0], m[r][i][1]); o.y = pk2(m[r][i][2], m[r][i][3]); st_nt2(xo + (lane + 64 * i) * 4, o); }
                }
                if (STAGE != 2) {
                    s2 = wave_sum(s2);
                    const float r2 = rsqrtf(s2 * (1.0f / D) + EPS);
#pragma unroll
                    for (int i = 0; i < 4; ++i) { const f32x4 gg = *(const f32x4*)(gnext + (lane + 64 * i) * 4);
                        u32x2 o; o.x = pk2(m[r][i][0] * r2 * gg[0], m[r][i][1] * r2 * gg[1]); o.y = pk2(m[r][i][2] * r2 * gg[2], m[r][i][3] * r2 * gg[3]);
                        *(u32x2*)(h + (size_t)row * D + (lane + 64 * i) * 4) = o; }
                } } }
    }
}
DI void unpack8(const u32x4 u, float* f) { f[0] = bflo(u.x); f[1] = bfhi(u.x); f[2] = bflo(u.y); f[3] = bfhi(u.y); f[4] = bflo(u.z); f[5] = bfhi(u.z); f[6] = bflo(u.w); f[7] = bfhi(u.w); }
DI void rowpass_cat(const Params& p) {
    const int wid = threadIdx.x >> 6, lane = threadIdx.x & 63;
    bf16_t* cat = (bf16_t*)(p.ws + O_H);
    for (int row = blockIdx.x * 8 + wid; row < T; row += gridDim.x * 8) {
#pragma unroll
        for (int hf = 0; hf < 2; ++hf) {
            bf16_t* cr = cat + (size_t)row * 1024 + hf * 512 + lane * 8; const float* g = (hf ? p.in[31] : p.in[26]) + lane * 8;
            float v[8]; unpack8(*(const u32x4*)cr, v); float ss = 0.f;
#pragma unroll
            for (int i = 0; i < 8; ++i) ss += v[i] * v[i];
            ss = wave_sum(ss); const float rs = rsqrtf(ss * (1.0f / 512) + EPS);
            const f32x4 g0 = *(const f32x4*)g, g1 = *(const f32x4*)(g + 4);
            u32x4 o; o.x = pk2(v[0] * rs * g0[0], v[1] * rs * g0[1]); o.y = pk2(v[2] * rs * g0[2], v[3] * rs * g0[3]); o.z = pk2(v[4] * rs * g1[0], v[5] * rs * g1[1]); o.w = pk2(v[6] * rs * g1[2], v[7] * rs * g1[3]);
            *(u32x4*)cr = o;
        }
    }
}

DI void tables_phase0(const Params& p) {
    const int gtid = blockIdx.x * blockDim.x + threadIdx.x, gsz = gridDim.x * blockDim.x;
    f32x2* rope = (f32x2*)(p.ws + O_ROPE); f32x2* lbp = (f32x2*)(p.ws + O_LBP); f32x2* bb = (f32x2*)(p.ws + O_BB);
    for (int idx = gtid; idx < 4096 * 16; idx += gsz) { const int pos = idx >> 4, i = idx & 15;
        const double inv = exp_d(-(double)i * 0.5756462732485115); double s, c; sincos_d((double)pos * inv, s, c); rope[idx] = (f32x2){(float)c, (float)s}; }
    for (int idx = gtid; idx < 32 * 2 * 33 * 64; idx += gsz) { const int pp = idx & 63, e = (idx >> 6) % 33, gd = idx / (64 * 33), dir = gd & 1, g = gd >> 1;
        const double re = p.in[dir ? 16 : 9][g * 64 + pp], im = p.in[dir ? 17 : 10][g * 64 + pp], dt = exp_d((double)p.in[dir ? 18 : 11][g]);
        const double mag = exp_d((double)e * re * dt); double s, c; sincos_d((double)e * im * dt, s, c); lbp[idx] = (f32x2){(float)(mag * c), (float)(mag * s)}; }
    for (int idx = gtid; idx < 32 * 2 * 64 * 16; idx += gsz) { const int j = idx & 15, pp = (idx >> 4) & 63, dir = (idx >> 10) & 1, g = idx >> 11;
        const double re = p.in[dir ? 16 : 9][g * 64 + pp], im = p.in[dir ? 17 : 10][g * 64 + pp], dt = exp_d((double)p.in[dir ? 18 : 11][g]);
        const double mag = exp_d(re * dt); double s, c; sincos_d(im * dt, s, c);
        const double nr = mag * c - 1.0, ni = mag * s, den = 1.0 / (re * re + im * im);
        const double qr = (nr * re + ni * im) * den, qi = (ni * re - nr * im) * den;
        const double br = p.in[dir ? 19 : 12][(g * 64 + pp) * 16 + j], bi = p.in[dir ? 20 : 13][(g * 64 + pp) * 16 + j];
        bb[idx] = (f32x2){(float)(qr * br - qi * bi), (float)(qr * bi + qi * br)}; }
}
DI void ktab_phase(const Params& p) {
    const int gtid = blockIdx.x * blockDim.x + threadIdx.x, gsz = gridDim.x * blockDim.x;
    const f32x2* lbp = (const f32x2*)(p.ws + O_LBP); const f32x2* bb = (const f32x2*)(p.ws + O_BB); float* kt = (float*)(p.ws + O_KTAB);
    for (int idx = gtid; idx < 32 * 2 * 32 * 256; idx += gsz) { const int j = idx & 15, i = (idx >> 4) & 15, d = (idx >> 8) & 31, dir = (idx >> 13) & 1, g = idx >> 14;
        const float* cre = p.in[dir ? 21 : 14] + (g * 16 + i) * 64; const float* cim = p.in[dir ? 22 : 15] + (g * 16 + i) * 64;
        const f32x2* lb = lbp + ((g * 2 + dir) * 33 + d) * 64; const f32x2* b = bb + (g * 2 + dir) * 64 * 16 + j;
        float acc = 0.f;
        for (int pp = 0; pp < 64; ++pp) { const float cr = cre[pp], ci = cim[pp]; const f32x2 l = lb[pp], bv = b[pp * 16];
            const float wr = cr * l.x - ci * l.y, wi = cr * l.y + ci * l.x; acc += wr * bv.x - wi * bv.y; }
        kt[idx] = acc; }
}
DI void expand_phase(const Params& p) {
    const int gtid = blockIdx.x * blockDim.x + threadIdx.x, gsz = gridDim.x * blockDim.x;
    const f32x2* __restrict__ lbp = (const f32x2*)(p.ws + O_LBP); const f32x2* __restrict__ bb = (const f32x2*)(p.ws + O_BB); const float* __restrict__ kt = (const float*)(p.ws + O_KTAB);
    bf16_t* __restrict__ Bs = (bf16_t*)(p.ws + O_BS); bf16_t* __restrict__ My = (bf16_t*)(p.ws + O_MY);
#pragma unroll 4
    for (int o8 = gtid; o8 < 32 * 256 * 512 / 8; o8 += gsz) { const int idx = o8 * 8, k = idx & 511, n = (idx >> 9) & 255, g = idx >> 17;
        const int s = k >> 4, j = k & 15, dr = n >> 6, dir = dr >> 1, reim = dr & 1, pp = n & 63, e = dir ? s : 31 - s;
        const f32x2 l = lbp[((g * 2 + dir) * 33 + e) * 64 + pp]; const f32x4* bq = (const f32x4*)(bb + ((g * 2 + dir) * 64 + pp) * 16 + j);
        float v[8];
#pragma unroll
        for (int q = 0; q < 4; ++q) { const f32x4 b2 = bq[q];
            v[2 * q] = reim ? (l.x * b2[1] + l.y * b2[0]) : (l.x * b2[0] - l.y * b2[1]); v[2 * q + 1] = reim ? (l.x * b2[3] + l.y * b2[2]) : (l.x * b2[2] - l.y * b2[3]); }
        u32x4 w; w.x = pk2(v[0], v[1]); w.y = pk2(v[2], v[3]); w.z = pk2(v[4], v[5]); w.w = pk2(v[6], v[7]);
        *(u32x4*)(Bs + idx) = w; }
#pragma unroll 4
    for (int o8 = gtid; o8 < 32 * 512 * 768 / 8; o8 += gsz) { const int row = o8 / 96, k = (o8 - row * 96) * 8, n = row & 511, g = row >> 9, t = n >> 4, i = n & 15;
        float v[8];
        if (k < 512) { const int s = k >> 4, j = k & 15; const float* kg = kt + (size_t)g * 2 * 32 * 256 + i * 16 + j;
            if (t != s) { const float* q = t > s ? kg + (t - s) * 256 : kg + 32 * 256 + (s - t) * 256; const f32x4 a0 = *(const f32x4*)q, a1 = *(const f32x4*)(q + 4);
                v[0] = a0[0]; v[1] = a0[1]; v[2] = a0[2]; v[3] = a0[3]; v[4] = a1[0]; v[5] = a1[1]; v[6] = a1[2]; v[7] = a1[3]; }
            else { const f32x4 a0 = *(const f32x4*)kg, a1 = *(const f32x4*)(kg + 4), c0 = *(const f32x4*)(kg + 32 * 256), c1 = *(const f32x4*)(kg + 32 * 256 + 4); const float dsk = p.in[23][g * 16 + i];
#pragma unroll
                for (int q = 0; q < 4; ++q) { v[q] = a0[q] + c0[q] + (i == j + q ? dsk : 0.f); v[4 + q] = a1[q] + c1[q] + (i == j + 4 + q ? dsk : 0.f); } } }
        else { const int kk = k - 512, dir = kk >> 7, reim = (kk >> 6) & 1, pp = kk & 63, e = dir ? 32 - t : t + 1;
            const float* crp = p.in[dir ? 21 : 14] + (g * 16 + i) * 64 + pp; const float* cip = p.in[dir ? 22 : 15] + (g * 16 + i) * 64 + pp; const f32x4* lq = (const f32x4*)(lbp + ((g * 2 + dir) * 33 + e) * 64 + pp);
            const f32x4 cr0 = *(const f32x4*)crp, cr1 = *(const f32x4*)(crp + 4), ci0 = *(const f32x4*)cip, ci1 = *(const f32x4*)(cip + 4);
#pragma unroll
            for (int q = 0; q < 4; ++q) { const f32x4 l2 = lq[q]; const float cra = q < 2 ? cr0[2 * q] : cr1[2 * q - 4], crb = q < 2 ? cr0[2 * q + 1] : cr1[2 * q - 3], cia = q < 2 ? ci0[2 * q] : ci1[2 * q - 4], cib = q < 2 ? ci0[2 * q + 1] : ci1[2 * q - 3];
                v[2 * q] = reim ? -(cra * l2[1] + cia * l2[0]) : (cra * l2[0] - cia * l2[1]); v[2 * q + 1] = reim ? -(crb * l2[3] + cib * l2[2]) : (crb * l2[2] - cib * l2[3]); } }
        u32x4 w; w.x = pk2(v[0], v[1]); w.y = pk2(v[2], v[3]); w.z = pk2(v[4], v[5]); w.w = pk2(v[6], v[7]);
        *(u32x4*)(My + (size_t)o8 * 8) = w; }
}
DI void scan_unit(const Params& p, int g, int pm) {
    const f32x2* lbp = (const f32x2*)(p.ws + O_LBP); const float* S = (const float*)(p.ws + O_S); bf16_t* UA = (bf16_t*)(p.ws + O_UA);
    const int tid = threadIdx.x, pp = tid & 63, dir = (tid >> 6) & 1, sub = tid >> 7;
    const int nc = pm < 4 ? 128 : 64, nsub = pm < 4 ? 2 : 4;
    if (sub >= nsub) return;
    const int c0 = pm * 256 + sub * nc;
    const f32x2 lL = lbp[((g * 2 + dir) * 33 + 32) * 64 + pp];
    float ar = 0.f, ai = 0.f;
    const float* Sg = S + (size_t)g * NCH * 256 + dir * 128 + pp; bf16_t* Ug = UA + (size_t)g * NCH * 768 + 512 + dir * 128 + pp;
#pragma unroll 16
    for (int cc = 0; cc < nc; ++cc) { const int c = c0 + (dir ? nc - 1 - cc : cc);
        const float sr = Sg[(size_t)c * 256], si = Sg[(size_t)c * 256 + 64];
        Ug[(size_t)c * 768] = f2bf(ar); Ug[(size_t)c * 768 + 64] = f2bf(ai);
        const float nr = lL.x * ar - lL.y * ai + sr, ni = lL.x * ai + lL.y * ar + si; ar = nr; ai = ni; }
}

namespace pg8 {
constexpr int BM = 256, BK = 64, HALF = 128, HTB = HALF * BK * 2, STAGE_BYTES = 8 * HTB, NXCD = 8, WGM = 8;
DI int lds_byte(int r, int c) { const int st = (r >> 4) * 2 + (c >> 5), rr = r & 15, cc = c & 31, ob = rr * 64 + cc * 2; return st * 1024 + (ob ^ (((ob >> 9) & 1) << 5)); }
DI void stage_rc(int b, int& R, int& C) { const int st = b / 1024, sb = b % 1024, swz = sb ^ (((sb >> 9) & 1) << 5); R = (st >> 1) * 16 + swz / 64; C = (st & 1) * 32 + (swz % 64) / 2; }
DI int perm32(int rho) { const int n = rho >> 4, i = rho & 15; return 8 * (i >> 2) + 4 * n + (i & 3); }
struct Unit { int pm, pn, g; };
struct Gemm { const bf16_t* A; const bf16_t* Bt; int lda, ldb, K; size_t sA, sB; };
struct Order {
    int nM, nN, nB, nwg, G, c;
    DI void init(int M, int N, int nB_, int G_, int c_) { nM = M / BM; nN = N / BM; nB = nB_; nwg = nM * nN; G = G_; c = c_; }
    DI bool next(int i, Unit& u) const {
        const long L = (long)i * G + c; if (L >= (long)nwg * nB) return false;
        u.g = (int)(L / nwg); int wgid = (int)(L % nwg);
        if (nB == 1) {
            { const int q = nwg / NXCD, r = nwg % NXCD, xcd = wgid % NXCD, off = wgid / NXCD; wgid = (xcd < r ? xcd * (q + 1) : r * (q + 1) + (xcd - r) * q) + off; }
            const int nig = WGM * nN, gid = wgid / nig, fm = gid * WGM, gsz = (nM - fm) < WGM ? (nM - fm) : WGM;
            u.pm = fm + ((wgid % nig) % gsz); u.pn = (wgid % nig) / gsz;
        } else { u.pm = wgid % nM; u.pn = wgid / nM; }
        return true;
    }
};
template <class Epi>
DI void gemm_phase(LAS unsigned char* lds, const Gemm g, const Order& S, const Epi& E) {
    const int tid = threadIdx.x, wid = __builtin_amdgcn_readfirstlane(tid >> 6), lane = tid & 63, wr = wid >> 2, wc = wid & 3, fr = lane & 15, fq = lane >> 4;
    const int K = g.K, nt = K / BK;
    unsigned voffA[2], voffB[2];
#pragma unroll
    for (int i = 0; i < 2; ++i) { int R, C; stage_rc(tid * 16 + i * 8192, R, C); const int Rb = Epi::PERM ? ((R & ~31) + perm32(R & 31)) : R;
        voffA[i] = (unsigned)(R * g.lda + C) * 2u; voffB[i] = (unsigned)(Rb * g.ldb + C) * 2u; }
    const size_t kstep = (size_t)(BK * 2);
    const size_t hstepA = (size_t)HALF * g.lda * 2, hstepB = (size_t)HALF * g.ldb * 2;
    const size_t tstepA = 2 * hstepA, tstepB = 2 * hstepB;
    const unsigned ldsw = (unsigned)wid * 1024u;
    const int aoff = lds_byte(wr * 64 + fr, fq * 8), boff = lds_byte(wc * 32 + fr, fq * 8);
#define PG8_SA(b, h) (((b) * 2 + (h)) * HTB)
#define PG8_SB(b, h) ((4 + (b) * 2 + (h)) * HTB)
#define PG8_STAGE(bufoff, gbase, voff) do { _Pragma("unroll") for (int _i = 0; _i < 2; ++_i) \
        __builtin_amdgcn_global_load_lds((const unsigned*)((const char*)(gbase) + (voff)[_i]), (LAS unsigned*)(lds + (bufoff) + ldsw + _i * 8192), 16, 0, 0); } while (0)
#define PG8_LDA(dst, b, h) do { _Pragma("unroll") for (int m = 0; m < 4; ++m) _Pragma("unroll") for (int k = 0; k < 2; ++k) dst[m][k] = *(const LAS bf16x8*)(lds + PG8_SA(b, h) + aoff + m * 2048 + k * 1024); } while (0)
#define PG8_LDB(dst, b, h) do { _Pragma("unroll") for (int n = 0; n < 2; ++n) _Pragma("unroll") for (int k = 0; k < 2; ++k) dst[n][k] = *(const LAS bf16x8*)(lds + PG8_SB(b, h) + boff + n * 2048 + k * 1024); } while (0)
#define PG8_MMA(ai, bj, At, Bt) do { __builtin_amdgcn_s_setprio(1); _Pragma("unroll") for (int m = 0; m < 4; ++m) _Pragma("unroll") for (int n = 0; n < 2; ++n) _Pragma("unroll") for (int k = 0; k < 2; ++k) \
        acc[ai][bj][m][n] = __builtin_amdgcn_mfma_f32_16x16x32_bf16(Bt[n][k], At[m][k], acc[ai][bj][m][n], 0, 0, 0); __builtin_amdgcn_s_setprio(0); } while (0)
#define PG8_WAIT_V(n) asm volatile("s_waitcnt vmcnt(" #n ")" ::: "memory")
#define PG8_WAIT_L(n) asm volatile("s_waitcnt lgkmcnt(" #n ")" ::: "memory")
#define PG8_BAR __builtin_amdgcn_s_barrier()
#define PG8_SCHED __builtin_amdgcn_sched_barrier(0)
    Unit cur, nxt; int ui = 0;
    if (!S.next(0, cur)) return;
    f32x4 acc[2][2][4][2];
#pragma unroll
    for (int a = 0; a < 2; ++a)
#pragma unroll
        for (int b = 0; b < 2; ++b)
#pragma unroll
            for (int m = 0; m < 4; ++m)
#pragma unroll
                for (int n = 0; n < 2; ++n) acc[a][b][m][n] = (f32x4){0.f, 0.f, 0.f, 0.f};
    bf16x8 At[4][2], B0[2][2], B1[2][2];
    const char* cA = (const char*)g.A + (size_t)cur.g * g.sA * 2 + (size_t)cur.pm * tstepA; const char* cB = (const char*)g.Bt + (size_t)cur.g * g.sB * 2 + (size_t)cur.pn * tstepB;
    PG8_STAGE(PG8_SB(0, 0), cB, voffB); PG8_STAGE(PG8_SA(0, 0), cA, voffA); PG8_STAGE(PG8_SB(0, 1), cB + hstepB, voffB); PG8_STAGE(PG8_SA(0, 1), cA + hstepA, voffA);
    if (wr == 1) PG8_BAR;
    PG8_WAIT_V(4); PG8_BAR;
    PG8_STAGE(PG8_SB(1, 0), cB + kstep, voffB); PG8_STAGE(PG8_SA(1, 0), cA + kstep, voffA); PG8_STAGE(PG8_SB(1, 1), cB + hstepB + kstep, voffB);
    PG8_WAIT_V(6); PG8_BAR;
    for (;;) {
        const bool has_next = S.next(ui + 1, nxt);
        const char* nA = has_next ? (const char*)g.A + (size_t)nxt.g * g.sA * 2 + (size_t)nxt.pm * tstepA : cA; const char* nB = has_next ? (const char*)g.Bt + (size_t)nxt.g * g.sB * 2 + (size_t)nxt.pn * tstepB : cB;
#pragma unroll 1
        for (int t = 0; t < nt; t += 2) {
            const bool last = (t == nt - 2);
            const char* a1 = cA + (size_t)(t + 1) * kstep;
            const char* a2 = last ? nA : cA + (size_t)(t + 2) * kstep; const char* b2 = last ? nB : cB + (size_t)(t + 2) * kstep;
            const char* a3 = a2 + kstep; const char* b3 = b2 + kstep;
            if constexpr (Epi::MID) { if (t == (nt >> 1)) { int fr_ = fr, fq_ = fq; asm volatile("" : "+v"(fr_), "+v"(fq_)); E.mid(acc, cur, wr, wc, fr_, fq_); } }
            PG8_LDB(B0, 0, 0); PG8_SCHED; PG8_LDA(At, 0, 0); PG8_STAGE(PG8_SA(1, 1), a1 + hstepA, voffA);
            PG8_WAIT_L(8); PG8_BAR; PG8_WAIT_L(0); PG8_MMA(0, 0, At, B0); PG8_BAR; PG8_SCHED;
            PG8_LDB(B1, 0, 1); PG8_STAGE(PG8_SB(0, 0), b2, voffB);
            PG8_BAR; PG8_WAIT_L(0); PG8_MMA(0, 1, At, B1); PG8_BAR;
            PG8_LDA(At, 0, 1); PG8_STAGE(PG8_SA(0, 0), a2, voffA);
            PG8_BAR; PG8_WAIT_L(0); PG8_MMA(1, 0, At, B0); PG8_BAR; PG8_SCHED;
            PG8_STAGE(PG8_SB(0, 1), b2 + hstepB, voffB);
            PG8_WAIT_V(6); PG8_BAR; PG8_MMA(1, 1, At, B1); PG8_BAR;
            PG8_LDB(B0, 1, 0); PG8_SCHED; PG8_LDA(At, 1, 0); PG8_STAGE(PG8_SA(0, 1), a2 + hstepA, voffA);
            PG8_WAIT_L(8); PG8_BAR; PG8_WAIT_L(0); PG8_MMA(0, 0, At, B0); PG8_BAR; PG8_SCHED;
            PG8_LDB(B1, 1, 1); PG8_STAGE(PG8_SB(1, 0), b3, voffB);
            PG8_BAR; PG8_WAIT_L(0); PG8_MMA(0, 1, At, B1); PG8_BAR;
            PG8_LDA(At, 1, 1); PG8_STAGE(PG8_SA(1, 0), a3, voffA);
            PG8_BAR; PG8_WAIT_L(0); PG8_MMA(1, 0, At, B0); PG8_BAR; PG8_SCHED;
            PG8_STAGE(PG8_SB(1, 1), b3 + hstepB, voffB);
            PG8_WAIT_V(6); PG8_BAR; PG8_MMA(1, 1, At, B1); PG8_BAR;
        }
        { int fr_ = fr, fq_ = fq; asm volatile("" : "+v"(fr_), "+v"(fq_)); E(acc, cur, wr, wc, fr_, fq_); }
        if (!has_next) break;
#pragma unroll
        for (int a = 0; a < 2; ++a)
#pragma unroll
            for (int b = 0; b < 2; ++b)
#pragma unroll
                for (int m = 0; m < 4; ++m)
#pragma unroll
                    for (int n = 0; n < 2; ++n) acc[a][b][m][n] = (f32x4){0.f, 0.f, 0.f, 0.f};
        cur = nxt; cA = nA; cB = nB; ++ui;
    }
    PG8_WAIT_V(0);
    if (wr == 0) PG8_BAR;
    PG8_BAR;
#undef PG8_SA
#undef PG8_SB
#undef PG8_STAGE
#undef PG8_LDA
#undef PG8_LDB
#undef PG8_MMA
#undef PG8_WAIT_V
#undef PG8_WAIT_L
#undef PG8_BAR
#undef PG8_SCHED
}
typedef f32x4 Acc[2][2][4][2];

struct EpiF32 {
    static constexpr bool PERM = false, MID = false;
    float* C; int ldc; size_t sC;
    DI void operator()(const Acc& acc, const Unit& u, int wr, int wc, int fr, int fq) const {
        const int row0 = u.pm * BM + wr * 64 + fr, col0 = u.pn * BM + wc * 32 + 4 * fq;
        float* base = C + (size_t)u.g * sC;
#pragma unroll
        for (int ai = 0; ai < 2; ++ai)
#pragma unroll
            for (int m = 0; m < 4; ++m) { float* rowp = base + (size_t)(row0 + ai * HALF + m * 16) * ldc + col0;
#pragma unroll
                for (int bj = 0; bj < 2; ++bj)
#pragma unroll
                    for (int n = 0; n < 2; ++n) *(f32x4*)(rowp + bj * HALF + n * 16) = acc[ai][bj][m][n]; }
    }
};
DI u32x4 pack8(const f32x4 a, const f32x4 b) { u32x4 w; w.x = pk2(a[0], a[1]); w.y = pk2(a[2], a[3]); w.z = pk2(b[0], b[1]); w.w = pk2(b[2], b[3]); return w; }
struct EpiBf16 {
    static constexpr bool PERM = true, MID = false;
    bf16_t* O; int ldc;
    DI void operator()(const Acc& acc, const Unit& u, int wr, int wc, int fr, int fq) const {
        const int row0 = u.pm * BM + wr * 64 + fr, col0 = u.pn * BM + wc * 32 + 8 * fq;
#pragma unroll
        for (int ai = 0; ai < 2; ++ai)
#pragma unroll
            for (int m = 0; m < 4; ++m) { bf16_t* rowp = O + (size_t)(row0 + ai * HALF + m * 16) * ldc + col0;
#pragma unroll
                for (int bj = 0; bj < 2; ++bj) *(u32x4*)(rowp + bj * HALF) = pack8(acc[ai][bj][m][0], acc[ai][bj][m][1]); }
    }
};
struct EpiSwiGLU {
    static constexpr bool PERM = true, MID = false;
    bf16_t* O;
    DI void operator()(const Acc& acc, const Unit& u, int wr, int wc, int fr, int fq) const {
        const int row0 = u.pm * BM + wr * 64 + fr, col0 = u.pn * HALF + wc * 32 + 8 * fq;
#pragma unroll
        for (int ai = 0; ai < 2; ++ai)
#pragma unroll
            for (int m = 0; m < 4; ++m) { f32x4 v0, v1;
#pragma unroll
                for (int j = 0; j < 4; ++j) { v0[j] = siluf_(acc[ai][0][m][0][j]) * acc[ai][1][m][0][j]; v1[j] = siluf_(acc[ai][0][m][1][j]) * acc[ai][1][m][1][j]; }
                *(u32x4*)(O + (size_t)(row0 + ai * HALF + m * 16) * DFF + col0) = pack8(v0, v1); }
    }
};
struct EpiZ {
    static constexpr bool PERM = true, MID = false;
    bf16_t* UA; bf16_t* zq; bf16_t* kpe; float* ssq; const f32x2* rope;
    DI void operator()(const Acc& acc, const Unit& u, int wr, int wc, int fr, int fq) const {
        const int row0 = u.pm * BM + wr * 64 + fr;
#pragma unroll
        for (int ai = 0; ai < 2; ++ai)
#pragma unroll
            for (int m = 0; m < 4; ++m) { const int row = row0 + ai * HALF + m * 16;
#pragma unroll
                for (int bj = 0; bj < 2; ++bj) { const int c0 = u.pn * BM + bj * HALF + wc * 32 + 8 * fq; const f32x4 v0 = acc[ai][bj][m][0], v1 = acc[ai][bj][m][1];
                    if (c0 < 512) *(u32x4*)(UA + ((size_t)(c0 >> 4) * NCH + (row >> 5)) * 768 + (row & 31) * 16 + (c0 & 15)) = pack8(v0, v1);
                    else if (c0 < 1152) {
                        *(u32x4*)(zq + (size_t)row * 640 + (c0 - 512)) = pack8(v0, v1);
                        float s = v0[0] * v0[0] + v0[1] * v0[1] + v0[2] * v0[2] + v0[3] * v0[3] + v1[0] * v1[0] + v1[1] * v1[1] + v1[2] * v1[2] + v1[3] * v1[3];
                        s += __shfl_xor(s, 16); s += __shfl_xor(s, 32);
                        if (fq == 0) atomicAdd(ssq + (c0 < 896 ? 0 : T) + row, s);
                    } else if (c0 < 1184) {
                        int tb, L, pos; tokinfo(row, tb, L, pos); const f32x2* rp = rope + pos * 16 + ((c0 - 1152) >> 1);
                        const f32x2 c0_ = rp[0], c1_ = rp[1], c2_ = rp[2], c3_ = rp[3]; f32x4 w0, w1;
                        w0[0] = v0[0] * c0_.x - v0[1] * c0_.y; w0[1] = v0[0] * c0_.y + v0[1] * c0_.x; w0[2] = v0[2] * c1_.x - v0[3] * c1_.y; w0[3] = v0[2] * c1_.y + v0[3] * c1_.x;
                        w1[0] = v1[0] * c2_.x - v1[1] * c2_.y; w1[1] = v1[0] * c2_.y + v1[1] * c2_.x; w1[2] = v1[2] * c3_.x - v1[3] * c3_.y; w1[3] = v1[2] * c3_.y + v1[3] * c3_.x;
                        *(u32x4*)(kpe + (size_t)row * 32 + (c0 - 1152)) = pack8(w0, w1);
                    } } }
    }
};
struct EpiQ {
    static constexpr bool PERM = true, MID = false;
    bf16_t* Q; const f32x2* rope; float qs; const float* ssq;
    DI void operator()(const Acc& acc, const Unit& u, int wr, int wc, int fr, int fq) const {
        const int row0 = u.pm * BM + wr * 64 + fr;
#pragma unroll
        for (int ai = 0; ai < 2; ++ai)
#pragma unroll
            for (int m = 0; m < 4; ++m) { const int row = row0 + ai * HALF + m * 16; int tb, L, pos; tokinfo(row, tb, L, pos);
#pragma unroll
                for (int bj = 0; bj < 2; ++bj) { const int c0 = u.pn * BM + bj * HALF + wc * 32 + 8 * fq; const int head = c0 / 96, d0 = c0 - head * 96;
                    f32x4 v0 = acc[ai][bj][m][0], v1 = acc[ai][bj][m][1];
                    if (d0 >= 64) { const int i0 = (d0 - 64) >> 1; const f32x2* rp = rope + pos * 16 + i0;
                        const f32x2 c0_ = rp[0], c1_ = rp[1], c2_ = rp[2], c3_ = rp[3];
                        const f32x4 t0 = v0, t1 = v1;
                        v0[0] = t0[0] * c0_.x - t0[1] * c0_.y; v0[1] = t0[0] * c0_.y + t0[1] * c0_.x; v0[2] = t0[2] * c1_.x - t0[3] * c1_.y; v0[3] = t0[2] * c1_.y + t0[3] * c1_.x;
                        v1[0] = t1[0] * c2_.x - t1[1] * c2_.y; v1[1] = t1[0] * c2_.y + t1[1] * c2_.x; v1[2] = t1[2] * c3_.x - t1[3] * c3_.y; v1[3] = t1[2] * c3_.y + t1[3] * c3_.x; }
                    { const float f = qs * rsqrtf(ssq[row] * (1.0f / 384) + EPS); v0 *= f; v1 *= f; }
                    *(u32x4*)(Q + ((size_t)tb * 8 + (size_t)head * L + pos) * 96 + d0) = pack8(v0, v1); } }
    }
};
struct EpiKV {
    static constexpr bool PERM = true, MID = false;
    bf16_t* Kn; bf16_t* Vt; const float* sskv;
    DI void operator()(const Acc& acc, const Unit& u, int wr, int wc, int fr, int fq) const {
        const int row0 = u.pm * BM + wr * 64 + fr;
#pragma unroll
        for (int ai = 0; ai < 2; ++ai)
#pragma unroll
            for (int m = 0; m < 4; ++m) { const int row = row0 + ai * HALF + m * 16; int tb, L, pos; tokinfo(row, tb, L, pos);
                const float f = rsqrtf(sskv[row] * (1.0f / 256) + EPS);
#pragma unroll
                for (int bj = 0; bj < 2; ++bj) { const int c0 = u.pn * BM + bj * HALF + wc * 32 + 8 * fq; const int head = c0 >> 7, d0 = c0 & 127;
                    const f32x4 v0 = acc[ai][bj][m][0] * f, v1 = acc[ai][bj][m][1] * f;
                    if (d0 < 64) *(u32x4*)(Kn + ((size_t)tb * 8 + (size_t)head * L + pos) * 64 + d0) = pack8(v0, v1);
                    else { bf16_t* vp = Vt + (size_t)tb * 512 + (size_t)(head * 64 + d0 - 64) * L + pos;
#pragma unroll
                        for (int j = 0; j < 4; ++j) { vp[(size_t)j * L] = f2bf(v0[j]); vp[(size_t)(j + 4) * L] = f2bf(v1[j]); } } } }
    }
};
struct EpiY {
    static constexpr bool PERM = true, MID = false;
    bf16_t* yg;
    DI void operator()(const Acc& acc, const Unit& u, int wr, int wc, int fr, int fq) const {
        const int row0 = u.pm * BM + wr * 64 + fr;
#pragma unroll
        for (int ai = 0; ai < 2; ++ai)
#pragma unroll
            for (int m = 0; m < 4; ++m) { const int ch = row0 + ai * HALF + m * 16;
#pragma unroll
                for (int bj = 0; bj < 2; ++bj) { const int n0 = u.pn * BM + bj * HALF + wc * 32 + 8 * fq; f32x4 v0, v1;
#pragma unroll
                    for (int j = 0; j < 4; ++j) { v0[j] = gelu_tanh(acc[ai][bj][m][0][j]); v1[j] = gelu_tanh(acc[ai][bj][m][1][j]); }
                    *(u32x4*)(yg + ((size_t)ch * 32 + (n0 >> 4)) * 512 + u.g * 16 + (n0 & 15)) = pack8(v0, v1); } }
    }
};
struct EpiGLU {
    static constexpr bool PERM = true, MID = false;
    const bf16_t* yg; const float* bias; bf16_t* cat; float* ss;
    DI void operator()(const Acc& acc, const Unit& u, int wr, int wc, int fr, int fq) const {
        const int row0 = u.pm * BM + wr * 64 + fr;
#pragma unroll
        for (int ai = 0; ai < 2; ++ai)
#pragma unroll
            for (int m = 0; m < 4; ++m) { const int row = row0 + ai * HALF + m * 16; float ssl = 0.f;
#pragma unroll
                for (int bj = 0; bj < 2; ++bj) { const int c0 = u.pn * BM + bj * HALF + wc * 32 + 8 * fq;
                    float y[8]; unpack8(*(const u32x4*)(yg + (size_t)row * 512 + c0), y);
                    const f32x4 b0 = *(const f32x4*)(bias + c0), b1 = *(const f32x4*)(bias + c0 + 4); f32x4 v0, v1;
#pragma unroll
                    for (int j = 0; j < 4; ++j) { v0[j] = y[j] * sigmoidf_(acc[ai][bj][m][0][j] + b0[j]); v1[j] = y[4 + j] * sigmoidf_(acc[ai][bj][m][1][j] + b1[j]); ssl += v0[j] * v0[j] + v1[j] * v1[j]; }
                    *(u32x4*)(cat + (size_t)row * 1024 + c0) = pack8(v0, v1); }
                ssl += __shfl_xor(ssl, 16); ssl += __shfl_xor(ssl, 32);
                if (fq == 0) atomicAdd(ss + row, ssl); }
    }
};
struct EpiOut {
    static constexpr bool PERM = true, MID = true;
    bf16_t* O; const float* ss;
    DI void mid(Acc& acc, const Unit& u, int wr, int wc, int fr, int fq) const {
        const int row0 = u.pm * BM + wr * 64 + fr;
#pragma unroll
        for (int ai = 0; ai < 2; ++ai)
#pragma unroll
            for (int m = 0; m < 4; ++m) { const int row = row0 + ai * HALF + m * 16;
                const float f = rsqrtf(ss[row] * (1.0f / 512) + EPS) * sqrtf(ss[T + row] * (1.0f / 512) + EPS);
#pragma unroll
                for (int bj = 0; bj < 2; ++bj) { acc[ai][bj][m][0] *= f; acc[ai][bj][m][1] *= f; } }
    }
    DI void operator()(const Acc& acc, const Unit& u, int wr, int wc, int fr, int fq) const {
        const int row0 = u.pm * BM + wr * 64 + fr, col0 = u.pn * BM + wc * 32 + 8 * fq;
#pragma unroll
        for (int ai = 0; ai < 2; ++ai)
#pragma unroll
            for (int m = 0; m < 4; ++m) { const int row = row0 + ai * HALF + m * 16; const float f = rsqrtf(ss[T + row] * (1.0f / 512) + EPS);
#pragma unroll
                for (int bj = 0; bj < 2; ++bj) *(u32x4*)(O + (size_t)row * 1024 + col0 + bj * HALF) = pack8(acc[ai][bj][m][0] * f, acc[ai][bj][m][1] * f); }
    }
};
}

template <class Epi> DI void run_gemm(LAS unsigned char* lds, const bf16_t* A, int lda, size_t sA, const bf16_t* Bt, int ldb, size_t sB, int M, int N, int K, int nB, const Epi& E, int crot = 0) {
    pg8::Gemm g; g.A = A; g.Bt = Bt; g.lda = lda; g.ldb = ldb; g.K = K; g.sA = sA; g.sB = sB;
    pg8::Order S; S.init(M, N, nB, (int)gridDim.x, (int)((blockIdx.x + crot) % gridDim.x));
    pg8::gemm_phase<Epi>(lds, g, S, E);
}

#define MFMA32(a, b, c) __builtin_amdgcn_mfma_f32_32x32x16_bf16((a), (b), (c), 0, 0, 0)
DI bf16x8 pack_p(const f32x16& x, int s) {
    u32x4 w; w.x = pk2(x[8 * s], x[8 * s + 1]); w.y = pk2(x[8 * s + 2], x[8 * s + 3]); w.z = pk2(x[8 * s + 4], x[8 * s + 5]); w.w = pk2(x[8 * s + 6], x[8 * s + 7]);
    return __builtin_bit_cast(bf16x8, w);
}
constexpr int KS_LD = 104, VS_LD = 68;
constexpr int KS_BYTES = 64 * KS_LD * 2, VS_BYTES = 64 * VS_LD * 2;
DI float xhalf_max(float v) { const auto r = __builtin_amdgcn_permlane32_swap(__float_as_uint(v), __float_as_uint(v), false, false); return fmaxf(__uint_as_float(r[0]), __uint_as_float(r[1])); }
DI float xhalf_sum(float v) { const auto r = __builtin_amdgcn_permlane32_swap(__float_as_uint(v), __float_as_uint(v), false, false); return __uint_as_float(r[0]) + __uint_as_float(r[1]); }
DI float max3f(float a, float b, float c) { return __builtin_fmaxf(__builtin_fmaxf(a, b), c); }
DI float max16(const f32x16& x) {
    const float a = max3f(x[0], x[1], x[2]), b = max3f(x[3], x[4], x[5]), c = max3f(x[6], x[7], x[8]), d = max3f(x[9], x[10], x[11]), e = max3f(x[12], x[13], x[14]);
    return max3f(max3f(a, b, c), d, max3f(e, x[15], x[15]));
}
DI void exp16(f32x16& x, float& sum) {
#pragma unroll
    for (int i = 0; i < 16; ++i) { x[i] = __builtin_amdgcn_exp2f(x[i]); sum += x[i]; }
}
constexpr float ATT_THRESH = 5.0f;
DI void attn_phase(const Params& p, unsigned char* smem) {
    const int tid = threadIdx.x, wid = tid >> 6, lane = tid & 63, r = lane & 31, hh = lane >> 5;
    const bf16_t* Qg = (const bf16_t*)(p.ws + O_Q); const bf16_t* Kg = (const bf16_t*)(p.ws + O_KN); const bf16_t* Vg = (const bf16_t*)(p.ws + O_VT); const bf16_t* Pg = (const bf16_t*)(p.ws + O_KPE);
    bf16_t* cat = (bf16_t*)(p.ws + O_H);
    const int G = gridDim.x; const int vb = (G & 7) ? (int)blockIdx.x : (int)((blockIdx.x & 7) * (G >> 3) + (blockIdx.x >> 3));
    for (int u = vb; u < 768; u += G) {
        int s, h, qt, L, tb;
        if (u < 512) { s = u >> 6; h = (u >> 3) & 7; qt = u & 7; L = LP; tb = s * LP; }
        else { const int v = u - 512; s = v >> 5; h = (v >> 2) & 7; qt = v & 3; L = LS; tb = TP + s * LS; }
        const bf16_t* Qb = Qg + ((size_t)tb * 8 + (size_t)h * L) * 96;
        const bf16_t* Kb = Kg + ((size_t)tb * 8 + (size_t)h * L) * 64;
        const bf16_t* Vb = Vg + (size_t)tb * 512 + (size_t)h * 64 * L;
        const bf16_t* Pb = Pg + (size_t)tb * 32;
        const int q = qt * 512 + wid * 64 + r;
        bf16x8 qa[6], qb[6];
#pragma unroll
        for (int s6 = 0; s6 < 6; ++s6) { qa[s6] = *(const bf16x8*)(Qb + (size_t)q * 96 + 16 * s6 + 8 * hh); qb[s6] = *(const bf16x8*)(Qb + (size_t)(q + 32) * 96 + 16 * s6 + 8 * hh); }
        f32x16 o0a, o1a, o0b, o1b;
#pragma unroll
        for (int i = 0; i < 16; ++i) { o0a[i] = 0.f; o1a[i] = 0.f; o0b[i] = 0.f; o1b[i] = 0.f; }
        float ma = 0.f, mb = 0.f, la = 0.f, lb = 0.f;
        asm volatile("" : "+v"(ma), "+v"(mb));
        const int nkt = L / 64;
#define ATT_OPAQUE_TID(t) int t = tid; asm volatile("" : "+v"(t))
        u32x4 kreg, vreg; u32x2 preg;
        auto load_tile = [&](int t) { ATT_OPAQUE_TID(t1); const int key = t1 >> 3, part = t1 & 7;
            kreg = *(const u32x4*)(Kb + (size_t)t * 4096 + (unsigned)(key * 64 + part * 8));
            preg = *(const u32x2*)(Pb + (size_t)t * 2048 + (unsigned)(key * 32 + part * 4));
            vreg = *(const u32x4*)(Vb + (size_t)t * 64 + (unsigned)(key * L + part * 8)); };
        auto write_tile = [&](int kbuf, int vbuf) { ATT_OPAQUE_TID(t4); const int key = t4 >> 3, part = t4 & 7;
            bf16_t* Kw = (bf16_t*)(smem + kbuf * KS_BYTES); bf16_t* Vw = (bf16_t*)(smem + 2 * KS_BYTES + vbuf * VS_BYTES);
            *(u32x4*)(Kw + key * KS_LD + part * 8) = kreg;
            *(u32x2*)(Kw + key * KS_LD + 64 + part * 4) = preg;
            *(u32x2*)(Vw + key * VS_LD + part * 8) = (u32x2){vreg.x, vreg.y}; *(u32x2*)(Vw + key * VS_LD + part * 8 + 4) = (u32x2){vreg.z, vreg.w}; };
        f32x16 s0a, s1a, s0b, s1b;
        auto s_stage = [&](int kbuf) {
            const bf16_t* Ks = (const bf16_t*)(smem + kbuf * KS_BYTES);
#pragma unroll
            for (int i = 0; i < 16; ++i) { s0a[i] = -ma; s1a[i] = -ma; s0b[i] = -mb; s1b[i] = -mb; }
            ATT_OPAQUE_TID(t2); const int r2 = t2 & 31, h2 = (t2 >> 5) & 1; const bf16_t* kp = Ks + r2 * KS_LD + 8 * h2;
            bf16x8 f0[2], f1[2];
            f0[0] = *(const bf16x8*)(kp); f1[0] = *(const bf16x8*)(kp + 32 * KS_LD);
            __builtin_amdgcn_sched_group_barrier(0x100, 2, 0);
#pragma unroll
            for (int s6 = 0; s6 < 6; ++s6) {
                if (s6 + 1 < 6) { f0[(s6 + 1) & 1] = *(const bf16x8*)(kp + 16 * (s6 + 1)); f1[(s6 + 1) & 1] = *(const bf16x8*)(kp + 32 * KS_LD + 16 * (s6 + 1)); }
                const bf16x8 a0 = f0[s6 & 1], a1 = f1[s6 & 1];
                s0a = MFMA32(a0, qa[s6], s0a); s0b = MFMA32(a0, qb[s6], s0b); s1a = MFMA32(a1, qa[s6], s1a); s1b = MFMA32(a1, qb[s6], s1b);
                if (s6 + 1 < 6) __builtin_amdgcn_sched_group_barrier(0x100, 2, 0);
                __builtin_amdgcn_sched_group_barrier(0x008, 4, 0);
            } };
        auto softmax_stage = [&](bool first) {
            float mxa = fmaxf(max16(s0a), max16(s1a)), mxb = fmaxf(max16(s0b), max16(s1b));
            mxa = xhalf_max(mxa); mxb = xhalf_max(mxb);
            if (first || __builtin_amdgcn_ballot_w64(fmaxf(mxa, mxb) > ATT_THRESH) != 0ull) {
                const float da = first ? mxa : fmaxf(mxa, 0.f), db = first ? mxb : fmaxf(mxb, 0.f);
                const float aa = __builtin_amdgcn_exp2f(-fabsf(da)), ab = __builtin_amdgcn_exp2f(-fabsf(db));
                ma += da; mb += db; la *= aa; lb *= ab;
#pragma unroll
                for (int i = 0; i < 16; ++i) { s0a[i] -= da; s1a[i] -= da; s0b[i] -= db; s1b[i] -= db; o0a[i] *= aa; o1a[i] *= aa; o0b[i] *= ab; o1b[i] *= ab; }
            }
            exp16(s0a, la); exp16(s1a, la); exp16(s0b, lb); exp16(s1b, lb); };
        auto pv_stage = [&](int vbuf) {
            const bf16_t* Vs = (const bf16_t*)(smem + 2 * KS_BYTES + vbuf * VS_BYTES);
            ATT_OPAQUE_TID(t3); const int r3 = t3 & 31, h3 = (t3 >> 5) & 1; const bf16_t* vp = Vs + r3 * VS_LD + 4 * h3;
            bf16x8 g0[2], g1[2];
            { const s16x4 lo0 = *(const s16x4*)vp, hi0 = *(const s16x4*)(vp + 8), lo1 = *(const s16x4*)(vp + 32 * VS_LD), hi1 = *(const s16x4*)(vp + 32 * VS_LD + 8);
              g0[0] = __builtin_shufflevector(lo0, hi0, 0, 1, 2, 3, 4, 5, 6, 7); g1[0] = __builtin_shufflevector(lo1, hi1, 0, 1, 2, 3, 4, 5, 6, 7); }
            __builtin_amdgcn_sched_group_barrier(0x100, 2, 0);
#pragma unroll
            for (int st = 0; st < 4; ++st) {
                if (st + 1 < 4) { const bf16_t* v0p = vp + 16 * (st + 1); const bf16_t* v1p = v0p + 32 * VS_LD;
                    const s16x4 lo0 = *(const s16x4*)v0p, hi0 = *(const s16x4*)(v0p + 8), lo1 = *(const s16x4*)v1p, hi1 = *(const s16x4*)(v1p + 8);
                    g0[(st + 1) & 1] = __builtin_shufflevector(lo0, hi0, 0, 1, 2, 3, 4, 5, 6, 7); g1[(st + 1) & 1] = __builtin_shufflevector(lo1, hi1, 0, 1, 2, 3, 4, 5, 6, 7); }
                const bf16x8 pa = pack_p((st >> 1) ? s1a : s0a, st & 1), pb = pack_p((st >> 1) ? s1b : s0b, st & 1);
                const bf16x8 vf0 = g0[st & 1], vf1 = g1[st & 1];
                o0a = MFMA32(vf0, pa, o0a); o0b = MFMA32(vf0, pb, o0b); o1a = MFMA32(vf1, pa, o1a); o1b = MFMA32(vf1, pb, o1b);
            } };
        load_tile(0); write_tile(0, 0);
        __syncthreads();
        if (wid < 4) {
            int vcur = 0;
            for (int kt = 0; kt < nkt; ++kt) {
                const int vnext = vcur == 2 ? 0 : vcur + 1;
                if (kt + 1 < nkt) load_tile(kt + 1);
                s_stage(kt & 1);
                softmax_stage(kt == 0); pv_stage(vcur);
                if (kt + 1 < nkt) write_tile((kt + 1) & 1, vnext);
                vcur = vnext;
                __syncthreads();
            }
        } else {
            int vcur = 0, vprev = 0;
            for (int kt = 0; kt < nkt; ++kt) {
                const int vnext = vcur == 2 ? 0 : vcur + 1;
                if (kt + 1 < nkt) load_tile(kt + 1);
                if (kt > 0) { softmax_stage(kt == 1); pv_stage(vprev); }
                s_stage(kt & 1);

                if (kt + 1 < nkt) write_tile((kt + 1) & 1, vnext);
                vprev = vcur; vcur = vnext;
                __syncthreads();
            }
            softmax_stage(nkt == 1); pv_stage(vprev);
        }
        const float ia = 1.0f / xhalf_sum(la), ib = 1.0f / xhalf_sum(lb);
        { float qa2 = 0.f, qb2 = 0.f;
#pragma unroll
          for (int i = 0; i < 16; ++i) { qa2 += o0a[i] * o0a[i] + o1a[i] * o1a[i]; qb2 += o0b[i] * o0b[i] + o1b[i] * o1b[i]; }
          qa2 *= ia * ia; qb2 *= ib * ib; qa2 = xhalf_sum(qa2); qb2 = xhalf_sum(qb2);
          float* sso = (float*)(p.ws + O_SS) + T;
          if (hh == 0) { atomicAdd(sso + tb + q, qa2); atomicAdd(sso + tb + q + 32, qb2); } }
        bf16_t* orow = cat + (size_t)(tb + q) * 1024 + 512 + h * 64 + 4 * hh;
#pragma unroll
        for (int g4 = 0; g4 < 4; ++g4) {
            *(u32x2*)(orow + 8 * g4) = (u32x2){pk2(o0a[4 * g4] * ia, o0a[4 * g4 + 1] * ia), pk2(o0a[4 * g4 + 2] * ia, o0a[4 * g4 + 3] * ia)};
            *(u32x2*)(orow + 32 + 8 * g4) = (u32x2){pk2(o1a[4 * g4] * ia, o1a[4 * g4 + 1] * ia), pk2(o1a[4 * g4 + 2] * ia, o1a[4 * g4 + 3] * ia)};
            *(u32x2*)(orow + 32 * 1024 + 8 * g4) = (u32x2){pk2(o0b[4 * g4] * ib, o0b[4 * g4 + 1] * ib), pk2(o0b[4 * g4 + 2] * ib, o0b[4 * g4 + 3] * ib)};
            *(u32x2*)(orow + 32 * 1024 + 32 + 8 * g4) = (u32x2){pk2(o1b[4 * g4] * ib, o1b[4 * g4 + 1] * ib), pk2(o1b[4 * g4 + 2] * ib, o1b[4 * g4 + 3] * ib)};
        }
        __syncthreads();
    }
}

#define XB_TMO      128
#define XB_XCNT(j)  (256  + 64 * (j))
#define XB_XSUB(j)  (1280 + 64 * (j))
#define XB_XGEN(j)  (2304 + 64 * (j))
#define XB_TOP      3328
#define XB_TOPGEN   3392
#define XCD_BAR_WORDS 3456
#define XB_SPIN_CAP (1u << 22)
DI unsigned xb_ld(unsigned* p)              { return __hip_atomic_load(p, __ATOMIC_RELAXED, __HIP_MEMORY_SCOPE_AGENT); }
DI unsigned xb_add(unsigned* p, unsigned v) { return __hip_atomic_fetch_add(p, v, __ATOMIC_RELAXED, __HIP_MEMORY_SCOPE_AGENT); }
DI unsigned xb_xcc_id() { return (unsigned)__builtin_amdgcn_s_getreg((3 << 11) | 20) & 0xFu; }
#define XB_SPIN(cond, bar) do { unsigned _sp = 0; while (cond) { __builtin_amdgcn_s_sleep(1); \
    if ((++_sp & 255u) == 0u) { if (xb_ld(&(bar)[XB_TMO])) break; if (_sp > XB_SPIN_CAP) { atomicAdd(&(bar)[XB_TMO], 1u); break; } } } } while (0)
struct XcdBarrier { unsigned* bar; unsigned x; volatile LAS unsigned* st; };
DI XcdBarrier xcd_barrier_post(unsigned* bar, volatile LAS unsigned* st) {
    XcdBarrier b; b.bar = bar; b.x = xb_xcc_id(); b.st = st;
    if (threadIdx.x == 0) (void)xb_add(&bar[XB_XCNT(b.x)], 1u);
    return b;
}
DI void xcd_barrier_complete(unsigned* bar, unsigned x, unsigned& nloc, unsigned& nx) {
    const unsigned G = gridDim.x * gridDim.y * gridDim.z;
    unsigned sum, cnt, mine, sp = 0u;
    for (;;) {
        sum = 0u; cnt = 0u; mine = 0u;
#pragma unroll
        for (unsigned j = 0; j < 16; ++j) { const unsigned c = xb_ld(&bar[XB_XCNT(j)]); sum += c; cnt += (c > 0u) ? 1u : 0u; mine = (j == x) ? c : mine; }
        if (sum == G) break;
        __builtin_amdgcn_s_sleep(1);
        if ((++sp & 255u) == 0u) { if (xb_ld(&bar[XB_TMO])) break; if (sp > XB_SPIN_CAP) { atomicAdd(&bar[XB_TMO], 1u); break; } }
    }
    nloc = mine > 0u ? mine : 1u; nx = cnt > 0u ? cnt : 1u;
}
DI void xcd_barrier(const XcdBarrier& b) {
    asm volatile("s_waitcnt vmcnt(0)" ::: "memory");
    __syncthreads();
    if (threadIdx.x == 0) {
        unsigned* bar = b.bar;
        __builtin_amdgcn_s_waitcnt(0);
        unsigned nloc = b.st[0], nx = b.st[1];
        if (nloc == 0u) { xcd_barrier_complete(bar, b.x, nloc, nx); b.st[0] = nloc; b.st[1] = nx; }
        const unsigned old = xb_add(&bar[XB_XSUB(b.x)], 1u);
        const unsigned gen = old / nloc;
        if (old + 1u == (gen + 1u) * nloc) {
            __builtin_amdgcn_fence(__ATOMIC_RELEASE, "agent");
            asm volatile("s_waitcnt vmcnt(0)" ::: "memory");
            const unsigned og = xb_add(&bar[XB_TOP], 1u);
            const unsigned tg = og / nx;
            if (og + 1u == (tg + 1u) * nx) xb_add(&bar[XB_TOPGEN], 1u);
            else XB_SPIN(xb_ld(&bar[XB_TOPGEN]) == tg, bar);
            __builtin_amdgcn_fence(__ATOMIC_ACQUIRE, "agent");
            xb_add(&bar[XB_XGEN(b.x)], 1u);
            asm volatile("s_waitcnt vmcnt(0)" ::: "memory");
        } else {
            XB_SPIN(xb_ld(&bar[XB_XGEN(b.x)]) == gen, bar);
            __builtin_amdgcn_fence(__ATOMIC_ACQUIRE, "agent");
            asm volatile("s_waitcnt vmcnt(0)" ::: "memory");
        }
    }
    __syncthreads();
}

constexpr int NPHASE = 15;
#define PROBE_ATTN 0
#define PROBE_P1 0
#define PROBE_P0 0
#define PROBE_R2 0
#define PROBE_P56 0
#define PROBE_SYNC 0
#ifndef ONLY_PHASE
#define ONLY_PHASE -1
#endif
#define PH_ON(n) (ONLY_PHASE < 0 || ONLY_PHASE == (n))
__global__ void __launch_bounds__(512, 2) mega(Params p, int lo, int hi) {
    extern __shared__ __attribute__((aligned(16))) unsigned char shm[];
    cg::grid_group grid = cg::this_grid();
    LAS unsigned char* lds = (LAS unsigned char*)shm;
    unsigned char* ws = p.ws;
    bf16_t* H = (bf16_t*)(ws + O_H);
    volatile LAS unsigned* xst = (volatile LAS unsigned*)(shm + 131072);
    if (threadIdx.x == 0) { xst[0] = 0u; xst[1] = 0u; xst[2] = 0u; xst[3] = 0u; }
    __syncthreads();
    const XcdBarrier xb = xcd_barrier_post((unsigned*)(ws + O_BAR), xst);
    if (PH_ON(0) && lo <= 0 && 0 < hi) {
            float* tile = (float*)shm;
#if PROBE_P0
            int rep0 = -1; again0: ++rep0;
#endif
            conv_T<1>(p.in[3], 1024, DFF, (bf16_t*)(ws + O_WGU1), tile);
            conv_T<2>(p.in[4], 1024, DFF, (bf16_t*)(ws + O_WGU1), tile);
            conv_T<0>(p.in[5], DFF, 1024, (bf16_t*)(ws + O_WD1), tile);
            conv_T<4>(p.in[8], 1024, DIN, (bf16_t*)(ws + O_WIN), tile);
            conv_T<3>(p.in[28], 384, 768, (bf16_t*)(ws + O_WUQ), tile, p.in[27], p.in[27], 384);
            conv_T<0>(p.in[30], 256, 1024, (bf16_t*)(ws + O_WUKV), tile, p.in[29], p.in[29], 256);
            conv_T<0>(p.in[24], 512, 512, (bf16_t*)(ws + O_WGLU), tile);
            conv_T<0>(p.in[32], 1024, 1024, (bf16_t*)(ws + O_WOUT), tile, p.in[26], p.in[31], 512);
            { bf16_t* wp = (bf16_t*)(ws + O_WIN) + (size_t)DIN * 1024; for (int i = blockIdx.x * blockDim.x + threadIdx.x; i < (DINP - DIN) * 1024; i += gridDim.x * blockDim.x) wp[i] = 0; }
            { float* ssz = (float*)(ws + O_SS); for (int i = blockIdx.x * blockDim.x + threadIdx.x; i < 4 * T; i += gridDim.x * blockDim.x) ssz[i] = 0.f; }
            tables_phase0(p);
            rowpass_first(p);
#if PROBE_P0
            if (rep0 == 0) { __syncthreads(); goto again0; }
#endif
    }
    if (lo <= 0 && 1 < hi) xcd_barrier(xb);
    if (PH_ON(1) && lo <= 1 && 1 < hi) {
            ktab_phase(p);
            pg8::EpiSwiGLU E; E.O = (bf16_t*)(ws + O_A);
            run_gemm(lds, H, 1024, 0, (const bf16_t*)(ws + O_WGU1), 1024, 0, T, 5632, 1024, 1, E);
#if PROBE_P1
            run_gemm(lds, H, 1024, 0, (const bf16_t*)(ws + O_WGU1), 1024, 0, T, 5632, 1024, 1, E);
#endif
    }
    if (lo <= 1 && 2 < hi) xcd_barrier(xb);
    if (PH_ON(2) && lo <= 2 && 2 < hi) {
            pg8::EpiBf16 E; E.O = H; E.ldc = 1024;
            run_gemm(lds, (const bf16_t*)(ws + O_A), DFF, 0, (const bf16_t*)(ws + O_WD1), DFF, 0, T, 1024, DFF, 1, E);
    }
    if (lo <= 2 && 3 < hi) xcd_barrier(xb);
    if (PH_ON(3) && lo <= 3 && 3 < hi) {
                        rowpass_res<0>(p, H, 0.5f, p.in[6], p.in[7], H);
            expand_phase(p);
    }
    if (lo <= 3 && 4 < hi) xcd_barrier(xb);
    if (PH_ON(4) && lo <= 4 && 4 < hi) {
            pg8::EpiZ E; E.UA = (bf16_t*)(ws + O_UA); E.zq = (bf16_t*)(ws + O_ZQ); E.kpe = (bf16_t*)(ws + O_KPE); E.ssq = (float*)(ws + O_SSQ); E.rope = (const f32x2*)(ws + O_ROPE);
            run_gemm(lds, H, 1024, 0, (const bf16_t*)(ws + O_WIN), 1024, 0, T, DINP, 1024, 1, E);
    }
    if (lo <= 4 && 5 < hi) xcd_barrier(xb);
    if (PH_ON(5) && lo <= 5 && 5 < hi) {
            { pg8::EpiF32 E; E.C = (float*)(ws + O_S); E.ldc = 256; E.sC = (size_t)NCH * 256;
              run_gemm(lds, (const bf16_t*)(ws + O_UA), 768, (size_t)NCH * 768, (const bf16_t*)(ws + O_BS), 512, (size_t)256 * 512, NCH, 256, 512, 32, E); }
            asm volatile("s_waitcnt vmcnt(0)" ::: "memory"); __syncthreads(); __threadfence();
            for (int L = blockIdx.x; L < 32 * 6; L += gridDim.x) scan_unit(p, L / 6, L % 6);
            __syncthreads();
#ifndef NO_P6A
            { pg8::EpiQ E; E.Q = (bf16_t*)(ws + O_Q); E.rope = (const f32x2*)(ws + O_ROPE); E.qs = 0.10206207261596577f * 1.4426950408889634f; E.ssq = (const float*)(ws + O_SSQ);
              run_gemm(lds, (const bf16_t*)(ws + O_ZQ), 640, 0, (const bf16_t*)(ws + O_WUQ), 384, 0, T, 768, 384, 1, E, (int)(gridDim.x >> 2)); }
#endif
#ifndef NO_P6B
            { pg8::EpiKV E; E.Kn = (bf16_t*)(ws + O_KN); E.Vt = (bf16_t*)(ws + O_VT); E.sskv = (const float*)(ws + O_SSQ) + T;
              run_gemm(lds, (const bf16_t*)(ws + O_ZQ) + 384, 640, 0, (const bf16_t*)(ws + O_WUKV), 256, 0, T, 1024, 256, 1, E); }
#endif
    }
    if (lo <= 5 && 6 < hi) xcd_barrier(xb);
    if (PH_ON(7) && lo <= 7 && 7 < hi) {
            { pg8::EpiY E; E.yg = (bf16_t*)(ws + O_YG);
              run_gemm(lds, (const bf16_t*)(ws + O_UA), 768, (size_t)NCH * 768, (const bf16_t*)(ws + O_MY), 768, (size_t)512 * 768, NCH, 512, 768, 32, E); }
            if (threadIdx.x >= 256) __builtin_amdgcn_s_setprio(1);
            attn_phase(p, shm);
            __builtin_amdgcn_s_setprio(0);
#if PROBE_ATTN
            __syncthreads(); attn_phase(p, shm);
#endif
    }
    if (lo <= 7 && 8 < hi) xcd_barrier(xb);
    if (PH_ON(8) && lo <= 8 && 8 < hi) {
            { float* tile = (float*)shm;
              conv_T<1>(p.in[35], 1024, DFF, (bf16_t*)(ws + O_WGU2), tile);
              conv_T<2>(p.in[36], 1024, DFF, (bf16_t*)(ws + O_WGU2), tile);
              conv_T<0>(p.in[37], DFF, 1024, (bf16_t*)(ws + O_WD2), tile);
              __syncthreads(); }
            pg8::EpiGLU E; E.yg = (const bf16_t*)(ws + O_YG); E.bias = p.in[25]; E.cat = H; E.ss = (float*)(ws + O_SS);
            run_gemm(lds, (const bf16_t*)(ws + O_YG), 512, 0, (const bf16_t*)(ws + O_WGLU), 512, 0, T, 512, 512, 1, E);
    }
    if (lo <= 8 && 9 < hi) xcd_barrier(xb);
    if (PH_ON(9) && lo <= 9 && 9 < hi) {
    }
    if (PH_ON(10) && lo <= 10 && 10 < hi) {
            pg8::EpiOut E; E.O = (bf16_t*)(ws + O_M2); E.ss = (const float*)(ws + O_SS);
            run_gemm(lds, H, 1024, 0, (const bf16_t*)(ws + O_WOUT), 1024, 0, T, 1024, 1024, 1, E);
    }
    if (lo <= 10 && 11 < hi) xcd_barrier(xb);
    if (PH_ON(11) && lo <= 11 && 11 < hi) {
            rowpass_res<1>(p, (const bf16_t*)(ws + O_M2), 1.0f, p.in[33], p.in[34], H);
    }
    if (lo <= 11 && 12 < hi) xcd_barrier(xb);
    if (PH_ON(12) && lo <= 12 && 12 < hi) {
            pg8::EpiSwiGLU E; E.O = (bf16_t*)(ws + O_A2);
            run_gemm(lds, H, 1024, 0, (const bf16_t*)(ws + O_WGU2), 1024, 0, T, 5632, 1024, 1, E);
    }
    if (lo <= 12 && 13 < hi) xcd_barrier(xb);
    if (PH_ON(13) && lo <= 13 && 13 < hi) {
            pg8::EpiBf16 E; E.O = H; E.ldc = 1024;
            run_gemm(lds, (const bf16_t*)(ws + O_A2), DFF, 0, (const bf16_t*)(ws + O_WD2), DFF, 0, T, 1024, DFF, 1, E);
    }
    if (lo <= 13 && 14 < hi) xcd_barrier(xb);
    if (PH_ON(14) && lo <= 14 && 14 < hi) {
            rowpass_res<2>(p, H, 0.5f, p.in[38], nullptr, H);
    }
    if (hi > NPHASE) grid.sync();
}

extern "C" void kernel_launch(void* const* d_in, const int* in_sizes, int n_in, void* d_out, int out_size, void* d_ws, size_t ws_size, hipStream_t stream) {
    constexpr size_t kDynLds = 131072 + 16;
    static int grid_blocks = 0;
    if (!grid_blocks) {
        int dev = 0, cus = 0, per_cu = 0;
        hipGetDevice(&dev);
        hipDeviceGetAttribute(&cus, hipDeviceAttributeMultiprocessorCount, dev);
        hipFuncSetAttribute((const void*)mega, hipFuncAttributeMaxDynamicSharedMemorySize, (int)kDynLds);
        hipOccupancyMaxActiveBlocksPerMultiprocessor(&per_cu, mega, 512, kDynLds);
        if (per_cu < 1) per_cu = 1;
        if (per_cu > 1) per_cu = 1;
        grid_blocks = cus * per_cu;
    }
    if (ws_size < O_TOTAL || n_in < 39) { fprintf(stderr, "workspace too small: %zu < %zu\n", ws_size, (size_t)O_TOTAL); return; }
    Params p{};
    for (int i = 0; i < 39; ++i) p.in[i] = (const float*)d_in[i];
    p.out = (float*)d_out; p.ws = (unsigned char*)d_ws;
    int lo = 0, hi = NPHASE;
    hipMemsetAsync((unsigned char*)d_ws + O_BAR, 0, 16384, stream);
    void* args[] = {&p, &lo, &hi};
    hipError_t e = hipLaunchCooperativeKernel((const void*)mega, dim3(grid_blocks), dim3(512), args, kDynLds, stream);
    if (e != hipSuccess) fprintf(stderr, "cooperative launch failed: %s (grid %d)\n", hipGetErrorString(e), grid_blocks);
}
```

```cpp
#include <hip/hip_runtime.h>
#include <hip/hip_cooperative_groups.h>
#include <cstdio>
namespace cg = cooperative_groups;

#define DI __device__ __forceinline__
#define LAS __attribute__((address_space(3)))
typedef unsigned short bf16_t;
typedef short bf16x8 __attribute__((ext_vector_type(8)));
typedef short s16x4 __attribute__((ext_vector_type(4)));
typedef float f32x2 __attribute__((ext_vector_type(2)));
typedef float f32x4 __attribute__((ext_vector_type(4)));
typedef float f32x16 __attribute__((ext_vector_type(16)));
typedef unsigned u32x2 __attribute__((ext_vector_type(2)));
typedef unsigned u32x4 __attribute__((ext_vector_type(4)));
typedef __bf16 bf16x2_t __attribute__((ext_vector_type(2)));

constexpr int T = 49152, TP = 32768, LP = 4096, LS = 2048, D = 1024, DFF = 2816, DIN = 1184, DINP = 1280;
constexpr int LC = 32, NCH = T / LC;
constexpr float EPS = 1e-6f;

constexpr size_t SZ_WGU = (size_t)5632 * 1024 * 2, SZ_WD = (size_t)1024 * 2816 * 2;
constexpr size_t O_WGU1 = 0;
constexpr size_t O_WD1 = O_WGU1 + SZ_WGU;
constexpr size_t O_WIN = O_WD1 + SZ_WD;
constexpr size_t O_WUQ = O_WIN + (size_t)DINP * 1024 * 2;
constexpr size_t O_WUKV = O_WUQ + (size_t)768 * 384 * 2;
constexpr size_t O_WGLU = O_WUKV + (size_t)1024 * 256 * 2;
constexpr size_t O_WOUT = O_WGLU + (size_t)512 * 512 * 2;
constexpr size_t O_BS = O_WOUT + (size_t)1024 * 1024 * 2;
constexpr size_t O_MY = O_BS + (size_t)32 * 256 * 512 * 2;
constexpr size_t O_ROPE = O_MY + (size_t)32 * 512 * 768 * 2;
constexpr size_t O_LBP = O_ROPE + (size_t)4096 * 16 * 8;
constexpr size_t O_BB = O_LBP + (size_t)32 * 2 * 33 * 64 * 8;
constexpr size_t O_KTAB = O_BB + (size_t)32 * 2 * 64 * 16 * 8;
constexpr size_t O_H = O_KTAB + (size_t)32 * 2 * 32 * 256 * 4;
constexpr size_t O_R = O_H + (size_t)T * 1024 * 2;
constexpr size_t O_UA = O_R;
constexpr size_t O_WGU2 = O_R;
constexpr size_t O_WD2 = O_WGU2 + SZ_WGU;
constexpr size_t O_ZQ = O_UA + (size_t)32 * NCH * 768 * 2;
constexpr size_t O_S = O_ZQ + (size_t)T * 640 * 2;
constexpr size_t O_YG = O_S;
constexpr size_t O_Q = O_S + (size_t)32 * NCH * 256 * 4;
constexpr size_t O_KPE = O_Q + (size_t)T * 768 * 2;
constexpr size_t O_KN = O_KPE + (size_t)T * 32 * 2;
constexpr size_t O_VT = O_KN + (size_t)T * 512 * 2;
constexpr size_t O_END = O_VT + (size_t)T * 512 * 2;
constexpr size_t O_BAR = O_END;
constexpr size_t O_SS = O_BAR + 16384;
constexpr size_t O_SSQ = O_SS + (size_t)2 * T * 4;
constexpr size_t O_TOTAL = O_SSQ + (size_t)2 * T * 4;
constexpr size_t O_A = O_ZQ;
constexpr size_t O_M2 = O_ZQ;
constexpr size_t O_A2 = O_WD2 + SZ_WD;
constexpr size_t O_X2A = O_A2 + (size_t)T * DFF * 2;
constexpr int X2_ROWS_A = (int)((O_END - O_X2A) / 2048);
constexpr size_t O_X2B = O_BS;
static_assert(O_X2A < O_END && X2_ROWS_A > 0 && X2_ROWS_A < T, "x2 split");
static_assert(O_X2B + (size_t)(T - X2_ROWS_A) * 2048 <= O_H, "x2 tail fits in the SSM area");
static_assert(O_A + (size_t)T * DFF * 2 <= O_END, "ffn hidden fits");
static_assert(O_M2 + (size_t)T * 1024 * 4 <= O_END, "m2 fits");
static_assert(O_WD2 + SZ_WD <= O_ZQ, "ffn2 weights fit in UA area");

struct Params { const float* in[39]; float* out; unsigned char* ws; };

DI unsigned pk2(float a, float b) { f32x2 v = {a, b}; bf16x2_t r = __builtin_convertvector(v, bf16x2_t); return __builtin_bit_cast(unsigned, r); }
DI bf16_t f2bf(float a) { return (bf16_t)(pk2(a, 0.f) & 0xffffu); }
DI float bflo(unsigned u) { return __uint_as_float(u << 16); }
DI float bfhi(unsigned u) { return __uint_as_float(u & 0xffff0000u); }
DI float bf2f(bf16_t b) { return __uint_as_float(((unsigned)b) << 16); }
DI f32x4 ld_nt(const float* p) { return __builtin_nontemporal_load((const f32x4*)p); }
DI u32x2 ld_nt2(const bf16_t* p) { return __builtin_nontemporal_load((const u32x2*)p); }
DI void st_nt(float* p, f32x4 v) { __builtin_nontemporal_store(v, (f32x4*)p); }
DI void st_nt2(bf16_t* p, u32x2 v) { __builtin_nontemporal_store(v, (u32x2*)p); }
DI float wave_sum(float v) {
#pragma unroll
    for (int o = 32; o >= 1; o >>= 1) v += __shfl_xor(v, o);
    return v;
}
DI float fast_rcp(float x) { return __builtin_amdgcn_rcpf(x); }
DI float fast_exp(float x) { return __builtin_amdgcn_exp2f(x * 1.4426950408889634f); }
DI float sigmoidf_(float x) { return fast_rcp(1.0f + fast_exp(-x)); }
DI float siluf_(float x) { return x * sigmoidf_(x); }
DI float gelu_tanh(float x) { const float z = 0.7978845608028654f * (x + 0.044715f * x * x * x); return x * sigmoidf_(2.0f * z); }
DI void tokinfo(int row, int& tb, int& L, int& pos) {
    if (row < TP) { tb = row & ~(LP - 1); L = LP; pos = row & (LP - 1); }
    else { const int r = row - TP; tb = TP + (r & ~(LS - 1)); L = LS; pos = r & (LS - 1); }
}
DI double exp_d(double x) {
    const double y = x * (1.0 / 64.0);
    double p = 1.0 + y * (1.0 + y * 0.5 * (1.0 + y * (1.0 / 3) * (1.0 + y * 0.25 * (1.0 + y * 0.2 * (1.0 + y * (1.0 / 6) * (1.0 + y * (1.0 / 7) * (1.0 + y * 0.125 * (1.0 + y * (1.0 / 9) * (1.0 + y * 0.1)))))))));
#pragma unroll
    for (int i = 0; i < 6; ++i) p *= p;
    return p;
}
DI void sincos_d(double ang, double& s, double& c) {
    double t = ang * 0.15915494309189535; t -= rint(t);
    const double r = t * (6.283185307179586 * 0.125), r2 = r * r;
    s = r * (1.0 - r2 * (1.0 / 6) * (1.0 - r2 * (1.0 / 20) * (1.0 - r2 * (1.0 / 42) * (1.0 - r2 * (1.0 / 72) * (1.0 - r2 * (1.0 / 110))))));
    c = 1.0 - r2 * 0.5 * (1.0 - r2 * (1.0 / 12) * (1.0 - r2 * (1.0 / 30) * (1.0 - r2 * (1.0 / 56) * (1.0 - r2 * (1.0 / 90)))));
#pragma unroll
    for (int i = 0; i < 3; ++i) { const double s2 = 2.0 * s * c, c2 = 1.0 - 2.0 * s * s; s = s2; c = c2; }
}

template <int MODE> DI int rowmap(int n) {
    if (MODE == 1) return ((n >> 7) << 8) + (n & 127);
    if (MODE == 2) return ((n >> 7) << 8) + 128 + (n & 127);
    if (MODE == 3) { const int h = n / 96, d = n - h * 96; const int dd = d < 64 ? d : (d < 80 ? 64 + 2 * (d - 64) : 65 + 2 * (d - 80)); return h * 96 + dd; }
    if (MODE == 4) return n < 1152 ? n : (n < 1168 ? 1152 + 2 * (n - 1152) : 1153 + 2 * (n - 1168));
    return n;
}
template <int MODE> DI void conv_T(const float* __restrict__ W, int K, int N, bf16_t* __restrict__ Wt, float* tile, const float* ga = nullptr, const float* gb = nullptr, int ksplit = 0) {
    const int tid = threadIdx.x, nkt = K / 64, nnt = (N + 63) / 64, ntl = nkt * nnt;
    auto ldtile = [&](int t, f32x4 (&v)[2]) { const int kt = t % nkt, ntile = t / nkt, k0 = kt * 64, n0 = ntile * 64;
#pragma unroll
        for (int r = 0; r < 2; ++r) { const int kl = (tid >> 4) + 32 * r, n = n0 + (tid & 15) * 4;
            v[r] = n < N ? ld_nt(W + (size_t)(k0 + kl) * N + n) : (f32x4){0.f, 0.f, 0.f, 0.f};
            if (ga) { const int k = k0 + kl; v[r] *= (k < ksplit ? ga[k] : gb[k - ksplit]); } } };
    f32x4 cur[2], nxt[2];
    int t = blockIdx.x;
    if (t < ntl) ldtile(t, cur);
    for (; t < ntl; t += gridDim.x) {
        const int kt = t % nkt, ntile = t / nkt, k0 = kt * 64, n0 = ntile * 64;
        const bool more = t + (int)gridDim.x < ntl;
        if (more) ldtile(t + gridDim.x, nxt);
        __syncthreads();
#pragma unroll
        for (int r = 0; r < 2; ++r) { const int kl = (tid >> 4) + 32 * r, nl = (tid & 15) * 4;
            tile[kl * 65 + nl] = cur[r][0]; tile[kl * 65 + nl + 1] = cur[r][1]; tile[kl * 65 + nl + 2] = cur[r][2]; tile[kl * 65 + nl + 3] = cur[r][3]; }
        __syncthreads();
#pragma unroll
        for (int r = 0; r < 2; ++r) { const int nl = (tid >> 4) + 32 * r, kq = (tid & 15) * 4, n = n0 + nl;
            if (n < N) { u32x2 o; o.x = pk2(tile[kq * 65 + nl], tile[(kq + 1) * 65 + nl]); o.y = pk2(tile[(kq + 2) * 65 + nl], tile[(kq + 3) * 65 + nl]);
                *(u32x2*)(Wt + (size_t)rowmap<MODE>(n) * K + k0 + kq) = o; } }
        if (more) { cur[0] = nxt[0]; cur[1] = nxt[1]; }
    }
}

constexpr int NR = 4;
DI void rowpass_first(const Params& p) {
    const int wid = threadIdx.x >> 6, lane = threadIdx.x & 63, stride = gridDim.x * 8;
    bf16_t* h = (bf16_t*)(p.ws + O_H);
    const float* g = p.in[2];
    for (int row0 = blockIdx.x * 8 + wid; row0 < T; row0 += NR * stride) {
        f32x4 v[NR][4]; float ss[NR];
#pragma unroll
        for (int r = 0; r < NR; ++r) { const int row = row0 + r * stride; ss[r] = 0.f;
            if (row < T) { const float* xr = row < TP ? p.in[0] + (size_t)row * D : p.in[1] + (size_t)(row - TP) * D;
#pragma unroll
                for (int i = 0; i < 4; ++i) v[r][i] = ld_nt(xr + (lane + 64 * i) * 4); } }
#pragma unroll
        for (int r = 0; r < NR; ++r) { const int row = row0 + r * stride;
            if (row < T) {
#pragma unroll
                for (int i = 0; i < 4; ++i) ss[r] += v[r][i][0] * v[r][i][0] + v[r][i][1] * v[r][i][1] + v[r][i][2] * v[r][i][2] + v[r][i][3] * v[r][i][3];
                ss[r] = wave_sum(ss[r]);
                const float rstd = rsqrtf(ss[r] * (1.0f / D) + EPS);
#pragma unroll
                for (int i = 0; i < 4; ++i) { const f32x4 gg = *(const f32x4*)(g + (lane + 64 * i) * 4);
                    u32x2 o; o.x = pk2(v[r][i][0] * rstd * gg[0], v[r][i][1] * rstd * gg[1]); o.y = pk2(v[r][i][2] * rstd * gg[2], v[r][i][3] * rstd * gg[3]);
                    *(u32x2*)(h + (size_t)row * D + (lane + 64 * i) * 4) = o; } } }
    }
}
DI bf16_t* x2_row(unsigned char* ws, int row) { return row < X2_ROWS_A ? (bf16_t*)(ws + O_X2A) + (size_t)row * D : (bf16_t*)(ws + O_X2B) + (size_t)(row - X2_ROWS_A) * D; }
template <int STAGE> DI void rowpass_res(const Params& p, const bf16_t* msrc, float alpha, const float* gpost, const float* gnext, bf16_t* h) {
    const int wid = threadIdx.x >> 6, lane = threadIdx.x & 63, stride = gridDim.x * 8;
    for (int row0 = blockIdx.x * 8 + wid; row0 < T; row0 += NR * stride) {
        f32x4 m[NR][4], x[NR][4];
#pragma unroll
        for (int r = 0; r < NR; ++r) { const int row = row0 + r * stride;
            if (row < T) {
#pragma unroll
                for (int i = 0; i < 4; ++i) { const u32x2 u = ld_nt2(msrc + (size_t)row * D + (lane + 64 * i) * 4); m[r][i][0] = bflo(u.x); m[r][i][1] = bfhi(u.x); m[r][i][2] = bflo(u.y); m[r][i][3] = bfhi(u.y); }
#pragma unroll
                for (int i = 0; i < 4; ++i) {
                    if (STAGE == 0) { const float* xr = row < TP ? p.in[0] + (size_t)row * D : p.in[1] + (size_t)(row - TP) * D; x[r][i] = ld_nt(xr + (lane + 64 * i) * 4); }
                    else { const bf16_t* xr = STAGE == 1 ? (const bf16_t*)p.out + (size_t)row * D : x2_row(p.ws, row);
                        const u32x2 u = ld_nt2(xr + (lane + 64 * i) * 4); x[r][i][0] = bflo(u.x); x[r][i][1] = bfhi(u.x); x[r][i][2] = bflo(u.y); x[r][i][3] = bfhi(u.y); } } } }
#pragma unroll
        for (int r = 0; r < NR; ++r) { const int row = row0 + r * stride;
            if (row < T) {
                float ss = 0.f;
#pragma unroll
                for (int i = 0; i < 4; ++i) ss += m[r][i][0] * m[r][i][0] + m[r][i][1] * m[r][i][1] + m[r][i][2] * m[r][i][2] + m[r][i][3] * m[r][i][3];
                ss = wave_sum(ss);
                const float rstd = rsqrtf(ss * (1.0f / D) + EPS) * alpha;
                float s2 = 0.f;
#pragma unroll
                for (int i = 0; i < 4; ++i) {
                    const f32x4 gg = *(const f32x4*)(gpost + (lane + 64 * i) * 4);
                    m[r][i] = x[r][i] + m[r][i] * rstd * gg; s2 += m[r][i][0] * m[r][i][0] + m[r][i][1] * m[r][i][1] + m[r][i][2] * m[r][i][2] + m[r][i][3] * m[r][i][3];
                    if (STAGE == 2) st_nt(p.out + (size_t)row * D + (lane + 64 * i) * 4, m[r][i]);
                    else { bf16_t* xo = STAGE == 0 ? (bf16_t*)p.out + (size_t)row * D : x2_row(p.ws, row);
                        u32x2 o; o.x = pk2(m[r][i][0], m[r][i][1]); o.y = pk2(m[r][i][2], m[r][i][3]); st_nt2(xo + (lane + 64 * i) * 4, o); }
                }
                if (STAGE != 2) {
                    s2 = wave_sum(s2);
                    const float r2 = rsqrtf(s2 * (1.0f / D) + EPS);
#pragma unroll
                    for (int i = 0; i < 4; ++i) { const f32x4 gg = *(const f32x4*)(gnext + (lane + 64 * i) * 4);
                        u32x2 o; o.x = pk2(m[r][i][0] * r2 * gg[0], m[r][i][1] * r2 * gg[1]); o.y = pk2(m[r][i][2] * r2 * gg[2], m[r][i][3] * r2 * gg[3]);
                        *(u32x2*)(h + (size_t)row * D + (lane + 64 * i) * 4) = o; }
                } } }
    }
}
DI void unpack8(const u32x4 u, float* f) { f[0] = bflo(u.x); f[1] = bfhi(u.x); f[2] = bflo(u.y); f[3] = bfhi(u.y); f[4] = bflo(u.z); f[5] = bfhi(u.z); f[6] = bflo(u.w); f[7] = bfhi(u.w); }
DI void rowpass_cat(const Params& p) {
    const int wid = threadIdx.x >> 6, lane = threadIdx.x & 63;
    bf16_t* cat = (bf16_t*)(p.ws + O_H);
    for (int row = blockIdx.x * 8 + wid; row < T; row += gridDim.x * 8) {
#pragma unroll
        for (int hf = 0; hf < 2; ++hf) {
            bf16_t* cr = cat + (size_t)row * 1024 + hf * 512 + lane * 8; const float* g = (hf ? p.in[31] : p.in[26]) + lane * 8;
            float v[8]; unpack8(*(const u32x4*)cr, v); float ss = 0.f;
#pragma unroll
            for (int i = 0; i < 8; ++i) ss += v[i] * v[i];
            ss = wave_sum(ss); const float rs = rsqrtf(ss * (1.0f / 512) + EPS);
            const f32x4 g0 = *(const f32x4*)g, g1 = *(const f32x4*)(g + 4);
            u32x4 o; o.x = pk2(v[0] * rs * g0[0], v[1] * rs * g0[1]); o.y = pk2(v[2] * rs * g0[2], v[3] * rs * g0[3]); o.z = pk2(v[4] * rs * g1[0], v[5] * rs * g1[1]); o.w = pk2(v[6] * rs * g1[2], v[7] * rs * g1[3]);
            *(u32x4*)cr = o;
        }
    }
}

DI void tables_phase0(const Params& p) {
    const int gtid = blockIdx.x * blockDim.x + threadIdx.x, gsz = gridDim.x * blockDim.x;
    f32x2* rope = (f32x2*)(p.ws + O_ROPE); f32x2* lbp = (f32x2*)(p.ws + O_LBP); f32x2* bb = (f32x2*)(p.ws + O_BB);
    for (int idx = gtid; idx < 4096 * 16; idx += gsz) { const int pos = idx >> 4, i = idx & 15;
        const double inv = exp_d(-(double)i * 0.5756462732485115); double s, c; sincos_d((double)pos * inv, s, c); rope[idx] = (f32x2){(float)c, (float)s}; }
    for (int idx = gtid; idx < 32 * 2 * 33 * 64; idx += gsz) { const int pp = idx & 63, e = (idx >> 6) % 33, gd = idx / (64 * 33), dir = gd & 1, g = gd >> 1;
        const double re = p.in[dir ? 16 : 9][g * 64 + pp], im = p.in[dir ? 17 : 10][g * 64 + pp], dt = exp_d((double)p.in[dir ? 18 : 11][g]);
        const double mag = exp_d((double)e * re * dt); double s, c; sincos_d((double)e * im * dt, s, c); lbp[idx] = (f32x2){(float)(mag * c), (float)(mag * s)}; }
    for (int idx = gtid; idx < 32 * 2 * 64 * 16; idx += gsz) { const int j = idx & 15, pp = (idx >> 4) & 63, dir = (idx >> 10) & 1, g = idx >> 11;
        const double re = p.in[dir ? 16 : 9][g * 64 + pp], im = p.in[dir ? 17 : 10][g * 64 + pp], dt = exp_d((double)p.in[dir ? 18 : 11][g]);
        const double mag = exp_d(re * dt); double s, c; sincos_d(im * dt, s, c);
        const double nr = mag * c - 1.0, ni = mag * s, den = 1.0 / (re * re + im * im);
        const double qr = (nr * re + ni * im) * den, qi = (ni * re - nr * im) * den;
        const double br = p.in[dir ? 19 : 12][(g * 64 + pp) * 16 + j], bi = p.in[dir ? 20 : 13][(g * 64 + pp) * 16 + j];
        bb[idx] = (f32x2){(float)(qr * br - qi * bi), (float)(qr * bi + qi * br)}; }
}
DI void ktab_phase(const Params& p) {
    const int gtid = blockIdx.x * blockDim.x + threadIdx.x, gsz = gridDim.x * blockDim.x;
    const f32x2* lbp = (const f32x2*)(p.ws + O_LBP); const f32x2* bb = (const f32x2*)(p.ws + O_BB); float* kt = (float*)(p.ws + O_KTAB);
    for (int idx = gtid; idx < 32 * 2 * 32 * 256; idx += gsz) { const int j = idx & 15, i = (idx >> 4) & 15, d = (idx >> 8) & 31, dir = (idx >> 13) & 1, g = idx >> 14;
        const float* cre = p.in[dir ? 21 : 14] + (g * 16 + i) * 64; const float* cim = p.in[dir ? 22 : 15] + (g * 16 + i) * 64;
        const f32x2* lb = lbp + ((g * 2 + dir) * 33 + d) * 64; const f32x2* b = bb + (g * 2 + dir) * 64 * 16 + j;
        float acc = 0.f;
        for (int pp = 0; pp < 64; ++pp) { const float cr = cre[pp], ci = cim[pp]; const f32x2 l = lb[pp], bv = b[pp * 16];
            const float wr = cr * l.x - ci * l.y, wi = cr * l.y + ci * l.x; acc += wr * bv.x - wi * bv.y; }
        kt[idx] = acc; }
}
DI void expand_phase(const Params& p) {
    const int gtid = blockIdx.x * blockDim.x + threadIdx.x, gsz = gridDim.x * blockDim.x;
    const f32x2* __restrict__ lbp = (const f32x2*)(p.ws + O_LBP); const f32x2* __restrict__ bb = (const f32x2*)(p.ws + O_BB); const float* __restrict__ kt = (const float*)(p.ws + O_KTAB);
    bf16_t* __restrict__ Bs = (bf16_t*)(p.ws + O_BS); bf16_t* __restrict__ My = (bf16_t*)(p.ws + O_MY);
#pragma unroll 4
    for (int o8 = gtid; o8 < 32 * 256 * 512 / 8; o8 += gsz) { const int idx = o8 * 8, k = idx & 511, n = (idx >> 9) & 255, g = idx >> 17;
        const int s = k >> 4, j = k & 15, dr = n >> 6, dir = dr >> 1, reim = dr & 1, pp = n & 63, e = dir ? s : 31 - s;
        const f32x2 l = lbp[((g * 2 + dir) * 33 + e) * 64 + pp]; const f32x4* bq = (const f32x4*)(bb + ((g * 2 + dir) * 64 + pp) * 16 + j);
        float v[8];
#pragma unroll
        for (int q = 0; q < 4; ++q) { const f32x4 b2 = bq[q];
            v[2 * q] = reim ? (l.x * b2[1] + l.y * b2[0]) : (l.x * b2[0] - l.y * b2[1]); v[2 * q + 1] = reim ? (l.x * b2[3] + l.y * b2[2]) : (l.x * b2[2] - l.y * b2[3]); }
        u32x4 w; w.x = pk2(v[0], v[1]); w.y = pk2(v[2], v[3]); w.z = pk2(v[4], v[5]); w.w = pk2(v[6], v[7]);
        *(u32x4*)(Bs + idx) = w; }
#pragma unroll 4
    for (int o8 = gtid; o8 < 32 * 512 * 768 / 8; o8 += gsz) { const int row = o8 / 96, k = (o8 - row * 96) * 8, n = row & 511, g = row >> 9, t = n >> 4, i = n & 15;
        float v[8];
        if (k < 512) { const int s = k >> 4, j = k & 15; const float* kg = kt + (size_t)g * 2 * 32 * 256 + i * 16 + j;
            if (t != s) { const float* q = t > s ? kg + (t - s) * 256 : kg + 32 * 256 + (s - t) * 256; const f32x4 a0 = *(const f32x4*)q, a1 = *(const f32x4*)(q + 4);
                v[0] = a0[0]; v[1] = a0[1]; v[2] = a0[2]; v[3] = a0[3]; v[4] = a1[0]; v[5] = a1[1]; v[6] = a1[2]; v[7] = a1[3]; }
            else { const f32x4 a0 = *(const f32x4*)kg, a1 = *(const f32x4*)(kg + 4), c0 = *(const f32x4*)(kg + 32 * 256), c1 = *(const f32x4*)(kg + 32 * 256 + 4); const float dsk = p.in[23][g * 16 + i];
#pragma unroll
                for (int q = 0; q < 4; ++q) { v[q] = a0[q] + c0[q] + (i == j + q ? dsk : 0.f); v[4 + q] = a1[q] + c1[q] + (i == j + 4 + q ? dsk : 0.f); } } }
        else { const int kk = k - 512, dir = kk >> 7, reim = (kk >> 6) & 1, pp = kk & 63, e = dir ? 32 - t : t + 1;
            const float* crp = p.in[dir ? 21 : 14] + (g * 16 + i) * 64 + pp; const float* cip = p.in[dir ? 22 : 15] + (g * 16 + i) * 64 + pp; const f32x4* lq = (const f32x4*)(lbp + ((g * 2 + dir) * 33 + e) * 64 + pp);
            const f32x4 cr0 = *(const f32x4*)crp, cr1 = *(const f32x4*)(crp + 4), ci0 = *(const f32x4*)cip, ci1 = *(const f32x4*)(cip + 4);
#pragma unroll
            for (int q = 0; q < 4; ++q) { const f32x4 l2 = lq[q]; const float cra = q < 2 ? cr0[2 * q] : cr1[2 * q - 4], crb = q < 2 ? cr0[2 * q + 1] : cr1[2 * q - 3], cia = q < 2 ? ci0[2 * q] : ci1[2 * q - 4], cib = q < 2 ? ci0[2 * q + 1] : ci1[2 * q - 3];
                v[2 * q] = reim ? -(cra * l2[1] + cia * l2[0]) : (cra * l2[0] - cia * l2[1]); v[2 * q + 1] = reim ? -(crb * l2[3] + cib * l2[2]) : (crb * l2[2] - cib * l2[3]); } }
        u32x4 w; w.x = pk2(v[0], v[1]); w.y = pk2(v[2], v[3]); w.z = pk2(v[4], v[5]); w.w = pk2(v[6], v[7]);
        *(u32x4*)(My + (size_t)o8 * 8) = w; }
}
DI void scan_unit(const Params& p, int g, int pm) {
    const f32x2* lbp = (const f32x2*)(p.ws + O_LBP); const float* S = (const float*)(p.ws + O_S); bf16_t* UA = (bf16_t*)(p.ws + O_UA);
    const int tid = threadIdx.x, pp = tid & 63, dir = (tid >> 6) & 1, sub = tid >> 7;
    const int nc = pm < 4 ? 128 : 64, nsub = pm < 4 ? 2 : 4;
    if (sub >= nsub) return;
    const int c0 = pm * 256 + sub * nc;
    const f32x2 lL = lbp[((g * 2 + dir) * 33 + 32) * 64 + pp];
    float ar = 0.f, ai = 0.f;
    const float* Sg = S + (size_t)g * NCH * 256 + dir * 128 + pp; bf16_t* Ug = UA + (size_t)g * NCH * 768 + 512 + dir * 128 + pp;
#pragma unroll 16
    for (int cc = 0; cc < nc; ++cc) { const int c = c0 + (dir ? nc - 1 - cc : cc);
        const float sr = Sg[(size_t)c * 256], si = Sg[(size_t)c * 256 + 64];
        Ug[(size_t)c * 768] = f2bf(ar); Ug[(size_t)c * 768 + 64] = f2bf(ai);
        const float nr = lL.x * ar - lL.y * ai + sr, ni = lL.x * ai + lL.y * ar + si; ar = nr; ai = ni; }
}

namespace pg8 {
constexpr int BM = 256, BK = 64, HALF = 128, HTB = HALF * BK * 2, STAGE_BYTES = 8 * HTB, NXCD = 8, WGM = 8;
DI int lds_byte(int r, int c) { const int st = (r >> 4) * 2 + (c >> 5), rr = r & 15, cc = c & 31, ob = rr * 64 + cc * 2; return st * 1024 + (ob ^ (((ob >> 9) & 1) << 5)); }
DI void stage_rc(int b, int& R, int& C) { const int st = b / 1024, sb = b % 1024, swz = sb ^ (((sb >> 9) & 1) << 5); R = (st >> 1) * 16 + swz / 64; C = (st & 1) * 32 + (swz % 64) / 2; }
DI int perm32(int rho) { const int n = rho >> 4, i = rho & 15; return 8 * (i >> 2) + 4 * n + (i & 3); }
struct Unit { int pm, pn, g; };
struct Gemm { const bf16_t* A; const bf16_t* Bt; int lda, ldb, K; size_t sA, sB; };
struct Order {
    int nM, nN, nB, nwg, G, c;
    DI void init(int M, int N, int nB_, int G_, int c_) { nM = M / BM; nN = N / BM; nB = nB_; nwg = nM * nN; G = G_; c = c_; }
    DI bool next(int i, Unit& u) const {
        const long L = (long)i * G + c; if (L >= (long)nwg * nB) return false;
        u.g = (int)(L / nwg); int wgid = (int)(L % nwg);
        if (nB == 1) {
            { const int q = nwg / NXCD, r = nwg % NXCD, xcd = wgid % NXCD, off = wgid / NXCD; wgid = (xcd < r ? xcd * (q + 1) : r * (q + 1) + (xcd - r) * q) + off; }
            const int nig = WGM * nN, gid = wgid / nig, fm = gid * WGM, gsz = (nM - fm) < WGM ? (nM - fm) : WGM;
            u.pm = fm + ((wgid % nig) % gsz); u.pn = (wgid % nig) / gsz;
        } else { u.pm = wgid % nM; u.pn = wgid / nM; }
        return true;
    }
};
template <class Epi>
DI void gemm_phase(LAS unsigned char* lds, const Gemm g, const Order& S, const Epi& E) {
    const int tid = threadIdx.x, wid = __builtin_amdgcn_readfirstlane(tid >> 6), lane = tid & 63, wr = wid >> 2, wc = wid & 3, fr = lane & 15, fq = lane >> 4;
    const int K = g.K, nt = K / BK;
    unsigned voffA[2], voffB[2];
#pragma unroll
    for (int i = 0; i < 2; ++i) { int R, C; stage_rc(tid * 16 + i * 8192, R, C); const int Rb = Epi::PERM ? ((R & ~31) + perm32(R & 31)) : R;
        voffA[i] = (unsigned)(R * g.lda + C) * 2u; voffB[i] = (unsigned)(Rb * g.ldb + C) * 2u; }
    const size_t kstep = (size_t)(BK * 2);
    const size_t hstepA = (size_t)HALF * g.lda * 2, hstepB = (size_t)HALF * g.ldb * 2;
    const size_t tstepA = 2 * hstepA, tstepB = 2 * hstepB;
    const unsigned ldsw = (unsigned)wid * 1024u;
    const int aoff = lds_byte(wr * 64 + fr, fq * 8), boff = lds_byte(wc * 32 + fr, fq * 8);
#define PG8_SA(b, h) (((b) * 2 + (h)) * HTB)
#define PG8_SB(b, h) ((4 + (b) * 2 + (h)) * HTB)
#define PG8_STAGE(bufoff, gbase, voff) do { _Pragma("unroll") for (int _i = 0; _i < 2; ++_i) \
        __builtin_amdgcn_global_load_lds((const unsigned*)((const char*)(gbase) + (voff)[_i]), (LAS unsigned*)(lds + (bufoff) + ldsw + _i * 8192), 16, 0, 0); } while (0)
#define PG8_LDA(dst, b, h) do { _Pragma("unroll") for (int m = 0; m < 4; ++m) _Pragma("unroll") for (int k = 0; k < 2; ++k) dst[m][k] = *(const LAS bf16x8*)(lds + PG8_SA(b, h) + aoff + m * 2048 + k * 1024); } while (0)
#define PG8_LDB(dst, b, h) do { _Pragma("unroll") for (int n = 0; n < 2; ++n) _Pragma("unroll") for (int k = 0; k < 2; ++k) dst[n][k] = *(const LAS bf16x8*)(lds + PG8_SB(b, h) + boff + n * 2048 + k * 1024); } while (0)
#define PG8_MMA(ai, bj, At, Bt) do { __builtin_amdgcn_s_setprio(1); _Pragma("unroll") for (int m = 0; m < 4; ++m) _Pragma("unroll") for (int n = 0; n < 2; ++n) _Pragma("unroll") for (int k = 0; k < 2; ++k) \
        acc[ai][bj][m][n] = __builtin_amdgcn_mfma_f32_16x16x32_bf16(Bt[n][k], At[m][k], acc[ai][bj][m][n], 0, 0, 0); __builtin_amdgcn_s_setprio(0); } while (0)
#define PG8_WAIT_V(n) asm volatile("s_waitcnt vmcnt(" #n ")" ::: "memory")
#define PG8_WAIT_L(n) asm volatile("s_waitcnt lgkmcnt(" #n ")" ::: "memory")
#define PG8_BAR __builtin_amdgcn_s_barrier()
#define PG8_SCHED __builtin_amdgcn_sched_barrier(0)
    Unit cur, nxt; int ui = 0;
    if (!S.next(0, cur)) return;
    f32x4 acc[2][2][4][2];
#pragma unroll
    for (int a = 0; a < 2; ++a)
#pragma unroll
        for (int b = 0; b < 2; ++b)
#pragma unroll
            for (int m = 0; m < 4; ++m)
#pragma unroll
                for (int n = 0; n < 2; ++n) acc[a][b][m][n] = (f32x4){0.f, 0.f, 0.f, 0.f};
    bf16x8 At[4][2], B0[2][2], B1[2][2];
    const char* cA = (const char*)g.A + (size_t)cur.g * g.sA * 2 + (size_t)cur.pm * tstepA; const char* cB = (const char*)g.Bt + (size_t)cur.g * g.sB * 2 + (size_t)cur.pn * tstepB;
    PG8_STAGE(PG8_SB(0, 0), cB, voffB); PG8_STAGE(PG8_SA(0, 0), cA, voffA); PG8_STAGE(PG8_SB(0, 1), cB + hstepB, voffB); PG8_STAGE(PG8_SA(0, 1), cA + hstepA, voffA);
    if (wr == 1) PG8_BAR;
    PG8_WAIT_V(4); PG8_BAR;
    PG8_STAGE(PG8_SB(1, 0), cB + kstep, voffB); PG8_STAGE(PG8_SA(1, 0), cA + kstep, voffA); PG8_STAGE(PG8_SB(1, 1), cB + hstepB + kstep, voffB);
    PG8_WAIT_V(6); PG8_BAR;
    for (;;) {
        const bool has_next = S.next(ui + 1, nxt);
        const char* nA = has_next ? (const char*)g.A + (size_t)nxt.g * g.sA * 2 + (size_t)nxt.pm * tstepA : cA; const char* nB = has_next ? (const char*)g.Bt + (size_t)nxt.g * g.sB * 2 + (size_t)nxt.pn * tstepB : cB;
#pragma unroll 1
        for (int t = 0; t < nt; t += 2) {
            const bool last = (t == nt - 2);
            const char* a1 = cA + (size_t)(t + 1) * kstep;
            const char* a2 = last ? nA : cA + (size_t)(t + 2) * kstep; const char* b2 = last ? nB : cB + (size_t)(t + 2) * kstep;
            const char* a3 = a2 + kstep; const char* b3 = b2 + kstep;
            if constexpr (Epi::MID) { if (t == (nt >> 1)) { int fr_ = fr, fq_ = fq; asm volatile("" : "+v"(fr_), "+v"(fq_)); E.mid(acc, cur, wr, wc, fr_, fq_); } }
            PG8_LDB(B0, 0, 0); PG8_SCHED; PG8_LDA(At, 0, 0); PG8_STAGE(PG8_SA(1, 1), a1 + hstepA, voffA);
            PG8_WAIT_L(8); PG8_BAR; PG8_WAIT_L(0); PG8_MMA(0, 0, At, B0); PG8_BAR; PG8_SCHED;
            PG8_LDB(B1, 0, 1); PG8_STAGE(PG8_SB(0, 0), b2, voffB);
            PG8_BAR; PG8_WAIT_L(0); PG8_MMA(0, 1, At, B1); PG8_BAR;
            PG8_LDA(At, 0, 1); PG8_STAGE(PG8_SA(0, 0), a2, voffA);
            PG8_BAR; PG8_WAIT_L(0); PG8_MMA(1, 0, At, B0); PG8_BAR; PG8_SCHED;
            PG8_STAGE(PG8_SB(0, 1), b2 + hstepB, voffB);
            PG8_WAIT_V(6); PG8_BAR; PG8_MMA(1, 1, At, B1); PG8_BAR;
            PG8_LDB(B0, 1, 0); PG8_SCHED; PG8_LDA(At, 1, 0); PG8_STAGE(PG8_SA(0, 1), a2 + hstepA, voffA);
            PG8_WAIT_L(8); PG8_BAR; PG8_WAIT_L(0); PG8_MMA(0, 0, At, B0); PG8_BAR; PG8_SCHED;
            PG8_LDB(B1, 1, 1); PG8_STAGE(PG8_SB(1, 0), b3, voffB);
            PG8_BAR; PG8_WAIT_L(0); PG8_MMA(0, 1, At, B1); PG8_BAR;
            PG8_LDA(At, 1, 1); PG8_STAGE(PG8_SA(1, 0), a3, voffA);
            PG8_BAR; PG8_WAIT_L(0); PG8_MMA(1, 0, At, B0); PG8_BAR; PG8_SCHED;
            PG8_STAGE(PG8_SB(1, 1), b3 + hstepB, voffB);
            PG8_WAIT_V(6); PG8_BAR; PG8_MMA(1, 1, At, B1); PG8_BAR;
        }
        { int fr_ = fr, fq_ = fq; asm volatile("" : "+v"(fr_), "+v"(fq_)); E(acc, cur, wr, wc, fr_, fq_); }
        if (!has_next) break;
#pragma unroll
        for (int a = 0; a < 2; ++a)
#pragma unroll
            for (int b = 0; b < 2; ++b)
#pragma unroll
                for (int m = 0; m < 4; ++m)
#pragma unroll
                    for (int n = 0; n < 2; ++n) acc[a][b][m][n] = (f32x4){0.f, 0.f, 0.f, 0.f};
        cur = nxt; cA = nA; cB = nB; ++ui;
    }
    PG8_WAIT_V(0);
    if (wr == 0) PG8_BAR;
    PG8_BAR;
#undef PG8_SA
#undef PG8_SB
#undef PG8_STAGE
#undef PG8_LDA
#undef PG8_LDB
#undef PG8_MMA
#undef PG8_WAIT_V
#undef PG8_WAIT_L
#undef PG8_BAR
#undef PG8_SCHED
}
typedef f32x4 Acc[2][2][4][2];

struct EpiF32 {
    static constexpr bool PERM = false, MID = false;
    float* C; int ldc; size_t sC;
    DI void operator()(const Acc& acc, const Unit& u, int wr, int wc, int fr, int fq) const {
        const int row0 = u.pm * BM + wr * 64 + fr, col0 = u.pn * BM + wc * 32 + 4 * fq;
        float* base = C + (size_t)u.g * sC;
#pragma unroll
        for (int ai = 0; ai < 2; ++ai)
#pragma unroll
            for (int m = 0; m < 4; ++m) { float* rowp = base + (size_t)(row0 + ai * HALF + m * 16) * ldc + col0;
#pragma unroll
                for (int bj = 0; bj < 2; ++bj)
#pragma unroll
                    for (int n = 0; n < 2; ++n) *(f32x4*)(rowp + bj * HALF + n * 16) = acc[ai][bj][m][n]; }
    }
};
DI u32x4 pack8(const f32x4 a, const f32x4 b) { u32x4 w; w.x = pk2(a[0], a[1]); w.y = pk2(a[2], a[3]); w.z = pk2(b[0], b[1]); w.w = pk2(b[2], b[3]); return w; }
struct EpiBf16 {
    static constexpr bool PERM = true, MID = false;
    bf16_t* O; int ldc;
    DI void operator()(const Acc& acc, const Unit& u, int wr, int wc, int fr, int fq) const {
        const int row0 = u.pm * BM + wr * 64 + fr, col0 = u.pn * BM + wc * 32 + 8 * fq;
#pragma unroll
        for (int ai = 0; ai < 2; ++ai)
#pragma unroll
            for (int m = 0; m < 4; ++m) { bf16_t* rowp = O + (size_t)(row0 + ai * HALF + m * 16) * ldc + col0;
#pragma unroll
                for (int bj = 0; bj < 2; ++bj) *(u32x4*)(rowp + bj * HALF) = pack8(acc[ai][bj][m][0], acc[ai][bj][m][1]); }
    }
};
struct EpiSwiGLU {
    static constexpr bool PERM = true, MID = false;
    bf16_t* O;
    DI void operator()(const Acc& acc, const Unit& u, int wr, int wc, int fr, int fq) const {
        const int row0 = u.pm * BM + wr * 64 + fr, col0 = u.pn * HALF + wc * 32 + 8 * fq;
#pragma unroll
        for (int ai = 0; ai < 2; ++ai)
#pragma unroll
            for (int m = 0; m < 4; ++m) { f32x4 v0, v1;
#pragma unroll
                for (int j = 0; j < 4; ++j) { v0[j] = siluf_(acc[ai][0][m][0][j]) * acc[ai][1][m][0][j]; v1[j] = siluf_(acc[ai][0][m][1][j]) * acc[ai][1][m][1][j]; }
                *(u32x4*)(O + (size_t)(row0 + ai * HALF + m * 16) * DFF + col0) = pack8(v0, v1); }
    }
};
struct EpiZ {
    static constexpr bool PERM = true, MID = false;
    bf16_t* UA; bf16_t* zq; bf16_t* kpe; float* ssq; const f32x2* rope;
    DI void operator()(const Acc& acc, const Unit& u, int wr, int wc, int fr, int fq) const {
        const int row0 = u.pm * BM + wr * 64 + fr;
#pragma unroll
        for (int ai = 0; ai < 2; ++ai)
#pragma unroll
            for (int m = 0; m < 4; ++m) { const int row = row0 + ai * HALF + m * 16;
#pragma unroll
                for (int bj = 0; bj < 2; ++bj) { const int c0 = u.pn * BM + bj * HALF + wc * 32 + 8 * fq; const f32x4 v0 = acc[ai][bj][m][0], v1 = acc[ai][bj][m][1];
                    if (c0 < 512) *(u32x4*)(UA + ((size_t)(c0 >> 4) * NCH + (row >> 5)) * 768 + (row & 31) * 16 + (c0 & 15)) = pack8(v0, v1);
                    else if (c0 < 1152) {
                        *(u32x4*)(zq + (size_t)row * 640 + (c0 - 512)) = pack8(v0, v1);
                        float s = v0[0] * v0[0] + v0[1] * v0[1] + v0[2] * v0[2] + v0[3] * v0[3] + v1[0] * v1[0] + v1[1] * v1[1] + v1[2] * v1[2] + v1[3] * v1[3];
                        s += __shfl_xor(s, 16); s += __shfl_xor(s, 32);
                        if (fq == 0) atomicAdd(ssq + (c0 < 896 ? 0 : T) + row, s);
                    } else if (c0 < 1184) {
                        int tb, L, pos; tokinfo(row, tb, L, pos); const f32x2* rp = rope + pos * 16 + ((c0 - 1152) >> 1);
                        const f32x2 c0_ = rp[0], c1_ = rp[1], c2_ = rp[2], c3_ = rp[3]; f32x4 w0, w1;
                        w0[0] = v0[0] * c0_.x - v0[1] * c0_.y; w0[1] = v0[0] * c0_.y + v0[1] * c0_.x; w0[2] = v0[2] * c1_.x - v0[3] * c1_.y; w0[3] = v0[2] * c1_.y + v0[3] * c1_.x;
                        w1[0] = v1[0] * c2_.x - v1[1] * c2_.y; w1[1] = v1[0] * c2_.y + v1[1] * c2_.x; w1[2] = v1[2] * c3_.x - v1[3] * c3_.y; w1[3] = v1[2] * c3_.y + v1[3] * c3_.x;
                        *(u32x4*)(kpe + (size_t)row * 32 + (c0 - 1152)) = pack8(w0, w1);
                    } } }
    }
};
struct EpiQ {
    static constexpr bool PERM = true, MID = false;
    bf16_t* Q; const f32x2* rope; float qs; const float* ssq;
    DI void operator()(const Acc& acc, const Unit& u, int wr, int wc, int fr, int fq) const {
        const int row0 = u.pm * BM + wr * 64 + fr;
#pragma unroll
        for (int ai = 0; ai < 2; ++ai)
#pragma unroll
            for (int m = 0; m < 4; ++m) { const int row = row0 + ai * HALF + m * 16; int tb, L, pos; tokinfo(row, tb, L, pos);
#pragma unroll
                for (int bj = 0; bj < 2; ++bj) { const int c0 = u.pn * BM + bj * HALF + wc * 32 + 8 * fq; const int head = c0 / 96, d0 = c0 - head * 96;
                    f32x4 v0 = acc[ai][bj][m][0], v1 = acc[ai][bj][m][1];
                    if (d0 >= 64) { const int i0 = (d0 - 64) >> 1; const f32x2* rp = rope + pos * 16 + i0;
                        const f32x2 c0_ = rp[0], c1_ = rp[1], c2_ = rp[2], c3_ = rp[3];
                        const f32x4 t0 = v0, t1 = v1;
                        v0[0] = t0[0] * c0_.x - t0[1] * c0_.y; v0[1] = t0[0] * c0_.y + t0[1] * c0_.x; v0[2] = t0[2] * c1_.x - t0[3] * c1_.y; v0[3] = t0[2] * c1_.y + t0[3] * c1_.x;
                        v1[0] = t1[0] * c2_.x - t1[1] * c2_.y; v1[1] = t1[0] * c2_.y + t1[1] * c2_.x; v1[2] = t1[2] * c3_.x - t1[3] * c3_.y; v1[3] = t1[2] * c3_.y + t1[3] * c3_.x; }
                    { const float f = qs * rsqrtf(ssq[row] * (1.0f / 384) + EPS); v0 *= f; v1 *= f; }
                    *(u32x4*)(Q + ((size_t)tb * 8 + (size_t)head * L + pos) * 96 + d0) = pack8(v0, v1); } }
    }
};
struct EpiKV {
    static constexpr bool PERM = true, MID = false;
    bf16_t* Kn; bf16_t* Vt; const float* sskv;
    DI void operator()(const Acc& acc, const Unit& u, int wr, int wc, int fr, int fq) const {
        const int row0 = u.pm * BM + wr * 64 + fr;
#pragma unroll
        for (int ai = 0; ai < 2; ++ai)
#pragma unroll
            for (int m = 0; m < 4; ++m) { const int row = row0 + ai * HALF + m * 16; int tb, L, pos; tokinfo(row, tb, L, pos);
                const float f = rsqrtf(sskv[row] * (1.0f / 256) + EPS);
#pragma unroll
                for (int bj = 0; bj < 2; ++bj) { const int c0 = u.pn * BM + bj * HALF + wc * 32 + 8 * fq; const int head = c0 >> 7, d0 = c0 & 127;
                    const f32x4 v0 = acc[ai][bj][m][0] * f, v1 = acc[ai][bj][m][1] * f;
                    if (d0 < 64) *(u32x4*)(Kn + ((size_t)tb * 8 + (size_t)head * L + pos) * 64 + d0) = pack8(v0, v1);
                    else { bf16_t* vp = Vt + (size_t)tb * 512 + (size_t)(head * 64 + d0 - 64) * L + pos;
#pragma unroll
                        for (int j = 0; j < 4; ++j) { vp[(size_t)j * L] = f2bf(v0[j]); vp[(size_t)(j + 4) * L] = f2bf(v1[j]); } } } }
    }
};
struct EpiY {
    static constexpr bool PERM = true, MID = false;
    bf16_t* yg;
    DI void operator()(const Acc& acc, const Unit& u, int wr, int wc, int fr, int fq) const {
        const int row0 = u.pm * BM + wr * 64 + fr;
#pragma unroll
        for (int ai = 0; ai < 2; ++ai)
#pragma unroll
            for (int m = 0; m < 4; ++m) { const int ch = row0 + ai * HALF + m * 16;
#pragma unroll
                for (int bj = 0; bj < 2; ++bj) { const int n0 = u.pn * BM + bj * HALF + wc * 32 + 8 * fq; f32x4 v0, v1;
#pragma unroll
                    for (int j = 0; j < 4; ++j) { v0[j] = gelu_tanh(acc[ai][bj][m][0][j]); v1[j] = gelu_tanh(acc[ai][bj][m][1][j]); }
                    *(u32x4*)(yg + ((size_t)ch * 32 + (n0 >> 4)) * 512 + u.g * 16 + (n0 & 15)) = pack8(v0, v1); } }
    }
};
struct EpiGLU {
    static constexpr bool PERM = true, MID = false;
    const bf16_t* yg; const float* bias; bf16_t* cat; float* ss;
    DI void operator()(const Acc& acc, const Unit& u, int wr, int wc, int fr, int fq) const {
        const int row0 = u.pm * BM + wr * 64 + fr;
#pragma unroll
        for (int ai = 0; ai < 2; ++ai)
#pragma unroll
            for (int m = 0; m < 4; ++m) { const int row = row0 + ai * HALF + m * 16; float ssl = 0.f;
#pragma unroll
                for (int bj = 0; bj < 2; ++bj) { const int c0 = u.pn * BM + bj * HALF + wc * 32 + 8 * fq;
                    float y[8]; unpack8(*(const u32x4*)(yg + (size_t)row * 512 + c0), y);
                    const f32x4 b0 = *(const f32x4*)(bias + c0), b1 = *(const f32x4*)(bias + c0 + 4); f32x4 v0, v1;
#pragma unroll
                    for (int j = 0; j < 4; ++j) { v0[j] = y[j] * sigmoidf_(acc[ai][bj][m][0][j] + b0[j]); v1[j] = y[4 + j] * sigmoidf_(acc[ai][bj][m][1][j] + b1[j]); ssl += v0[j] * v0[j] + v1[j] * v1[j]; }
                    *(u32x4*)(cat + (size_t)row * 1024 + c0) = pack8(v0, v1); }
                ssl += __shfl_xor(ssl, 16); ssl += __shfl_xor(ssl, 32);
                if (fq == 0) atomicAdd(ss + row, ssl); }
    }
};
struct EpiOut {
    static constexpr bool PERM = true, MID = true;
    bf16_t* O; const float* ss;
    DI void mid(Acc& acc, const Unit& u, int wr, int wc, int fr, int fq) const {
        const int row0 = u.pm * BM + wr * 64 + fr;
#pragma unroll
        for (int ai = 0; ai < 2; ++ai)
#pragma unroll
            for (int m = 0; m < 4; ++m) { const int row = row0 + ai * HALF + m * 16;
                const float f = rsqrtf(ss[row] * (1.0f / 512) + EPS) * sqrtf(ss[T + row] * (1.0f / 512) + EPS);
#pragma unroll
                for (int bj = 0; bj < 2; ++bj) { acc[ai][bj][m][0] *= f; acc[ai][bj][m][1] *= f; } }
    }
    DI void operator()(const Acc& acc, const Unit& u, int wr, int wc, int fr, int fq) const {
        const int row0 = u.pm * BM + wr * 64 + fr, col0 = u.pn * BM + wc * 32 + 8 * fq;
#pragma unroll
        for (int ai = 0; ai < 2; ++ai)
#pragma unroll
            for (int m = 0; m < 4; ++m) { const int row = row0 + ai * HALF + m * 16; const float f = rsqrtf(ss[T + row] * (1.0f / 512) + EPS);
#pragma unroll
                for (int bj = 0; bj < 2; ++bj) *(u32x4*)(O + (size_t)row * 1024 + col0 + bj * HALF) = pack8(acc[ai][bj][m][0] * f, acc[ai][bj][m][1] * f); }
    }
};
}

template <class Epi> DI void run_gemm(LAS unsigned char* lds, const bf16_t* A, int lda, size_t sA, const bf16_t* Bt, int ldb, size_t sB, int M, int N, int K, int nB, const Epi& E, int crot = 0) {
    pg8::Gemm g; g.A = A; g.Bt = Bt; g.lda = lda; g.ldb = ldb; g.K = K; g.sA = sA; g.sB = sB;
    pg8::Order S; S.init(M, N, nB, (int)gridDim.x, (int)((blockIdx.x + crot) % gridDim.x));
    pg8::gemm_phase<Epi>(lds, g, S, E);
}

#define MFMA32(a, b, c) __builtin_amdgcn_mfma_f32_32x32x16_bf16((a), (b), (c), 0, 0, 0)
DI bf16x8 pack_p(const f32x16& x, int s) {
    u32x4 w; w.x = pk2(x[8 * s], x[8 * s + 1]); w.y = pk2(x[8 * s + 2], x[8 * s + 3]); w.z = pk2(x[8 * s + 4], x[8 * s + 5]); w.w = pk2(x[8 * s + 6], x[8 * s + 7]);
    return __builtin_bit_cast(bf16x8, w);
}
constexpr int KS_LD = 104, VS_LD = 68;
constexpr int KS_BYTES = 64 * KS_LD * 2, VS_BYTES = 64 * VS_LD * 2;
DI float xhalf_max(float v) { const auto r = __builtin_amdgcn_permlane32_swap(__float_as_uint(v), __float_as_uint(v), false, false); return fmaxf(__uint_as_float(r[0]), __uint_as_float(r[1])); }
DI float xhalf_sum(float v) { const auto r = __builtin_amdgcn_permlane32_swap(__float_as_uint(v), __float_as_uint(v), false, false); return __uint_as_float(r[0]) + __uint_as_float(r[1]); }
DI float max3f(float a, float b, float c) { return __builtin_fmaxf(__builtin_fmaxf(a, b), c); }
DI float max16(const f32x16& x) {
    const float a = max3f(x[0], x[1], x[2]), b = max3f(x[3], x[4], x[5]), c = max3f(x[6], x[7], x[8]), d = max3f(x[9], x[10], x[11]), e = max3f(x[12], x[13], x[14]);
    return max3f(max3f(a, b, c), d, max3f(e, x[15], x[15]));
}
DI void exp16(f32x16& x, float& sum) {
#pragma unroll
    for (int i = 0; i < 16; ++i) { x[i] = __builtin_amdgcn_exp2f(x[i]); sum += x[i]; }
}
constexpr float ATT_THRESH = 5.0f;
DI void attn_phase(const Params& p, unsigned char* smem) {
    const int tid = threadIdx.x, wid = tid >> 6, lane = tid & 63, r = lane & 31, hh = lane >> 5;
    const bf16_t* Qg = (const bf16_t*)(p.ws + O_Q); const bf16_t* Kg = (const bf16_t*)(p.ws + O_KN); const bf16_t* Vg = (const bf16_t*)(p.ws + O_VT); const bf16_t* Pg = (const bf16_t*)(p.ws + O_KPE);
    bf16_t* cat = (bf16_t*)(p.ws + O_H);
    const int G = gridDim.x; const int vb = (G & 7) ? (int)blockIdx.x : (int)((blockIdx.x & 7) * (G >> 3) + (blockIdx.x >> 3));
    for (int u = vb; u < 768; u += G) {
        int s, h, qt, L, tb;
        if (u < 512) { s = u >> 6; h = (u >> 3) & 7; qt = u & 7; L = LP; tb = s * LP; }
        else { const int v = u - 512; s = v >> 5; h = (v >> 2) & 7; qt = v & 3; L = LS; tb = TP + s * LS; }
        const bf16_t* Qb = Qg + ((size_t)tb * 8 + (size_t)h * L) * 96;
        const bf16_t* Kb = Kg + ((size_t)tb * 8 + (size_t)h * L) * 64;
        const bf16_t* Vb = Vg + (size_t)tb * 512 + (size_t)h * 64 * L;
        const bf16_t* Pb = Pg + (size_t)tb * 32;
        const int q = qt * 512 + wid * 64 + r;
        bf16x8 qa[6], qb[6];
#pragma unroll
        for (int s6 = 0; s6 < 6; ++s6) { qa[s6] = *(const bf16x8*)(Qb + (size_t)q * 96 + 16 * s6 + 8 * hh); qb[s6] = *(const bf16x8*)(Qb + (size_t)(q + 32) * 96 + 16 * s6 + 8 * hh); }
        f32x16 o0a, o1a, o0b, o1b;
#pragma unroll
        for (int i = 0; i < 16; ++i) { o0a[i] = 0.f; o1a[i] = 0.f; o0b[i] = 0.f; o1b[i] = 0.f; }
        float ma = 0.f, mb = 0.f, la = 0.f, lb = 0.f;
        asm volatile("" : "+v"(ma), "+v"(mb));
        const int nkt = L / 64;
#define ATT_OPAQUE_TID(t) int t = tid; asm volatile("" : "+v"(t))
        u32x4 kreg, vreg; u32x2 preg;
        auto load_tile = [&](int t) { ATT_OPAQUE_TID(t1); const int key = t1 >> 3, part = t1 & 7;
            kreg = *(const u32x4*)(Kb + (size_t)t * 4096 + (unsigned)(key * 64 + part * 8));
            preg = *(const u32x2*)(Pb + (size_t)t * 2048 + (unsigned)(key * 32 + part * 4));
            vreg = *(const u32x4*)(Vb + (size_t)t * 64 + (unsigned)(key * L + part * 8)); };
        auto write_tile = [&](int kbuf, int vbuf) { ATT_OPAQUE_TID(t4); const int key = t4 >> 3, part = t4 & 7;
            bf16_t* Kw = (bf16_t*)(smem + kbuf * KS_BYTES); bf16_t* Vw = (bf16_t*)(smem + 2 * KS_BYTES + vbuf * VS_BYTES);
            *(u32x4*)(Kw + key * KS_LD + part * 8) = kreg;
            *(u32x2*)(Kw + key * KS_LD + 64 + part * 4) = preg;
            *(u32x2*)(Vw + key * VS_LD + part * 8) = (u32x2){vreg.x, vreg.y}; *(u32x2*)(Vw + key * VS_LD + part * 8 + 4) = (u32x2){vreg.z, vreg.w}; };
        f32x16 s0a, s1a, s0b, s1b;
        auto s_stage = [&](int kbuf) {
            const bf16_t* Ks = (const bf16_t*)(smem + kbuf * KS_BYTES);
#pragma unroll
            for (int i = 0; i < 16; ++i) { s0a[i] = -ma; s1a[i] = -ma; s0b[i] = -mb; s1b[i] = -mb; }
            ATT_OPAQUE_TID(t2); const int r2 = t2 & 31, h2 = (t2 >> 5) & 1; const bf16_t* kp = Ks + r2 * KS_LD + 8 * h2;
            bf16x8 f0[2], f1[2];
            f0[0] = *(const bf16x8*)(kp); f1[0] = *(const bf16x8*)(kp + 32 * KS_LD);
            __builtin_amdgcn_sched_group_barrier(0x100, 2, 0);
#pragma unroll
            for (int s6 = 0; s6 < 6; ++s6) {
                if (s6 + 1 < 6) { f0[(s6 + 1) & 1] = *(const bf16x8*)(kp + 16 * (s6 + 1)); f1[(s6 + 1) & 1] = *(const bf16x8*)(kp + 32 * KS_LD + 16 * (s6 + 1)); }
                const bf16x8 a0 = f0[s6 & 1], a1 = f1[s6 & 1];
                s0a = MFMA32(a0, qa[s6], s0a); s0b = MFMA32(a0, qb[s6], s0b); s1a = MFMA32(a1, qa[s6], s1a); s1b = MFMA32(a1, qb[s6], s1b);
                if (s6 + 1 < 6) __builtin_amdgcn_sched_group_barrier(0x100, 2, 0);
                __builtin_amdgcn_sched_group_barrier(0x008, 4, 0);
            } };
        auto softmax_stage = [&](bool first) {
            float mxa = fmaxf(max16(s0a), max16(s1a)), mxb = fmaxf(max16(s0b), max16(s1b));
            mxa = xhalf_max(mxa); mxb = xhalf_max(mxb);
            if (first || __builtin_amdgcn_ballot_w64(fmaxf(mxa, mxb) > ATT_THRESH) != 0ull) {
                const float da = first ? mxa : fmaxf(mxa, 0.f), db = first ? mxb : fmaxf(mxb, 0.f);
                const float aa = __builtin_amdgcn_exp2f(-fabsf(da)), ab = __builtin_amdgcn_exp2f(-fabsf(db));
                ma += da; mb += db; la *= aa; lb *= ab;
#pragma unroll
                for (int i = 0; i < 16; ++i) { s0a[i] -= da; s1a[i] -= da; s0b[i] -= db; s1b[i] -= db; o0a[i] *= aa; o1a[i] *= aa; o0b[i] *= ab; o1b[i] *= ab; }
            }
            exp16(s0a, la); exp16(s1a, la); exp16(s0b, lb); exp16(s1b, lb); };
        auto pv_stage = [&](int vbuf) {
            const bf16_t* Vs = (const bf16_t*)(smem + 2 * KS_BYTES + vbuf * VS_BYTES);
            ATT_OPAQUE_TID(t3); const int r3 = t3 & 31, h3 = (t3 >> 5) & 1; const bf16_t* vp = Vs + r3 * VS_LD + 4 * h3;
            bf16x8 g0[2], g1[2];
            { const s16x4 lo0 = *(const s16x4*)vp, hi0 = *(const s16x4*)(vp + 8), lo1 = *(const s16x4*)(vp + 32 * VS_LD), hi1 = *(const s16x4*)(vp + 32 * VS_LD + 8);
              g0[0] = __builtin_shufflevector(lo0, hi0, 0, 1, 2, 3, 4, 5, 6, 7); g1[0] = __builtin_shufflevector(lo1, hi1, 0, 1, 2, 3, 4, 5, 6, 7); }
            __builtin_amdgcn_sched_group_barrier(0x100, 2, 0);
#pragma unroll
            for (int st = 0; st < 4; ++st) {
                if (st + 1 < 4) { const bf16_t* v0p = vp + 16 * (st + 1); const bf16_t* v1p = v0p + 32 * VS_LD;
                    const s16x4 lo0 = *(const s16x4*)v0p, hi0 = *(const s16x4*)(v0p + 8), lo1 = *(const s16x4*)v1p, hi1 = *(const s16x4*)(v1p + 8);
                    g0[(st + 1) & 1] = __builtin_shufflevector(lo0, hi0, 0, 1, 2, 3, 4, 5, 6, 7); g1[(st + 1) & 1] = __builtin_shufflevector(lo1, hi1, 0, 1, 2, 3, 4, 5, 6, 7); }
                const bf16x8 pa = pack_p((st >> 1) ? s1a : s0a, st & 1), pb = pack_p((st >> 1) ? s1b : s0b, st & 1);
                const bf16x8 vf0 = g0[st & 1], vf1 = g1[st & 1];
                o0a = MFMA32(vf0, pa, o0a); o0b = MFMA32(vf0, pb, o0b); o1a = MFMA32(vf1, pa, o1a); o1b = MFMA32(vf1, pb, o1b);
            } };
        load_tile(0); write_tile(0, 0);
        __syncthreads();
        if (wid < 4) {
            int vcur = 0;
            for (int kt = 0; kt < nkt; ++kt) {
                const int vnext = vcur == 2 ? 0 : vcur + 1;
                if (kt + 1 < nkt) load_tile(kt + 1);
                s_stage(kt & 1);
                softmax_stage(kt == 0); pv_stage(vcur);
                if (kt + 1 < nkt) write_tile((kt + 1) & 1, vnext);
                vcur = vnext;
                __syncthreads();
            }
        } else {
            int vcur = 0, vprev = 0;
            for (int kt = 0; kt < nkt; ++kt) {
                const int vnext = vcur == 2 ? 0 : vcur + 1;
                if (kt + 1 < nkt) load_tile(kt + 1);
                if (kt > 0) { softmax_stage(kt == 1); pv_stage(vprev); }
                s_stage(kt & 1);

                if (kt + 1 < nkt) write_tile((kt + 1) & 1, vnext);
                vprev = vcur; vcur = vnext;
                __syncthreads();
            }
            softmax_stage(nkt == 1); pv_stage(vprev);
        }
        const float ia = 1.0f / xhalf_sum(la), ib = 1.0f / xhalf_sum(lb);
        { float qa2 = 0.f, qb2 = 0.f;
#pragma unroll
          for (int i = 0; i < 16; ++i) { qa2 += o0a[i] * o0a[i] + o1a[i] * o1a[i]; qb2 += o0b[i] * o0b[i] + o1b[i] * o1b[i]; }
          qa2 *= ia * ia; qb2 *= ib * ib; qa2 = xhalf_sum(qa2); qb2 = xhalf_sum(qb2);
          float* sso = (float*)(p.ws + O_SS) + T;
          if (hh == 0) { atomicAdd(sso + tb + q, qa2); atomicAdd(sso + tb + q + 32, qb2); } }
        bf16_t* orow = cat + (size_t)(tb + q) * 1024 + 512 + h * 64 + 4 * hh;
#pragma unroll
        for (int g4 = 0; g4 < 4; ++g4) {
            *(u32x2*)(orow + 8 * g4) = (u32x2){pk2(o0a[4 * g4] * ia, o0a[4 * g4 + 1] * ia), pk2(o0a[4 * g4 + 2] * ia, o0a[4 * g4 + 3] * ia)};
            *(u32x2*)(orow + 32 + 8 * g4) = (u32x2){pk2(o1a[4 * g4] * ia, o1a[4 * g4 + 1] * ia), pk2(o1a[4 * g4 + 2] * ia, o1a[4 * g4 + 3] * ia)};
            *(u32x2*)(orow + 32 * 1024 + 8 * g4) = (u32x2){pk2(o0b[4 * g4] * ib, o0b[4 * g4 + 1] * ib), pk2(o0b[4 * g4 + 2] * ib, o0b[4 * g4 + 3] * ib)};
            *(u32x2*)(orow + 32 * 1024 + 32 + 8 * g4) = (u32x2){pk2(o1b[4 * g4] * ib, o1b[4 * g4 + 1] * ib), pk2(o1b[4 * g4 + 2] * ib, o1b[4 * g4 + 3] * ib)};
        }
        __syncthreads();
    }
}

#define XB_TMO      128
#define XB_XCNT(j)  (256  + 64 * (j))
#define XB_XSUB(j)  (1280 + 64 * (j))
#define XB_XGEN(j)  (2304 + 64 * (j))
#define XB_TOP      3328
#define XB_TOPGEN   3392
#define XCD_BAR_WORDS 3456
#define XB_SPIN_CAP (1u << 22)
DI unsigned xb_ld(unsigned* p)              { return __hip_atomic_load(p, __ATOMIC_RELAXED, __HIP_MEMORY_SCOPE_AGENT); }
DI unsigned xb_add(unsigned* p, unsigned v) { return __hip_atomic_fetch_add(p, v, __ATOMIC_RELAXED, __HIP_MEMORY_SCOPE_AGENT); }
DI unsigned xb_xcc_id() { return (unsigned)__builtin_amdgcn_s_getreg((3 << 11) | 20) & 0xFu; }
#define XB_SPIN(cond, bar) do { unsigned _sp = 0; while (cond) { __builtin_amdgcn_s_sleep(1); \
    if ((++_sp & 255u) == 0u) { if (xb_ld(&(bar)[XB_TMO])) break; if (_sp > XB_SPIN_CAP) { atomicAdd(&(bar)[XB_TMO], 1u); break; } } } } while (0)
struct XcdBarrier { unsigned* bar; unsigned x; volatile LAS unsigned* st; };
DI XcdBarrier xcd_barrier_post(unsigned* bar, volatile LAS unsigned* st) {
    XcdBarrier b; b.bar = bar; b.x = xb_xcc_id(); b.st = st;
    if (threadIdx.x == 0) (void)xb_add(&bar[XB_XCNT(b.x)], 1u);
    return b;
}
DI void xcd_barrier_complete(unsigned* bar, unsigned x, unsigned& nloc, unsigned& nx) {
    const unsigned G = gridDim.x * gridDim.y * gridDim.z;
    unsigned sum, cnt, mine, sp = 0u;
    for (;;) {
        sum = 0u; cnt = 0u; mine = 0u;
#pragma unroll
        for (unsigned j = 0; j < 16; ++j) { const unsigned c = xb_ld(&bar[XB_XCNT(j)]); sum += c; cnt += (c > 0u) ? 1u : 0u; mine = (j == x) ? c : mine; }
        if (sum == G) break;
        __builtin_amdgcn_s_sleep(1);
        if ((++sp & 255u) == 0u) { if (xb_ld(&bar[XB_TMO])) break; if (sp > XB_SPIN_CAP) { atomicAdd(&bar[XB_TMO], 1u); break; } }
    }
    nloc = mine > 0u ? mine : 1u; nx = cnt > 0u ? cnt : 1u;
}
DI void xcd_barrier(const XcdBarrier& b) {
    asm volatile("s_waitcnt vmcnt(0)" ::: "memory");
    __syncthreads();
    if (threadIdx.x == 0) {
        unsigned* bar = b.bar;
        __builtin_amdgcn_s_waitcnt(0);
        unsigned nloc = b.st[0], nx = b.st[1];
        if (nloc == 0u) { xcd_barrier_complete(bar, b.x, nloc, nx); b.st[0] = nloc; b.st[1] = nx; }
        const unsigned old = xb_add(&bar[XB_XSUB(b.x)], 1u);
        const unsigned gen = old / nloc;
        if (old + 1u == (gen + 1u) * nloc) {
            __builtin_amdgcn_fence(__ATOMIC_RELEASE, "agent");
            asm volatile("s_waitcnt vmcnt(0)" ::: "memory");
            const unsigned og = xb_add(&bar[XB_TOP], 1u);
            const unsigned tg = og / nx;
            if (og + 1u == (tg + 1u) * nx) xb_add(&bar[XB_TOPGEN], 1u);
            else XB_SPIN(xb_ld(&bar[XB_TOPGEN]) == tg, bar);
            __builtin_amdgcn_fence(__ATOMIC_ACQUIRE, "agent");
            xb_add(&bar[XB_XGEN(b.x)], 1u);
            asm volatile("s_waitcnt vmcnt(0)" ::: "memory");
        } else {
            XB_SPIN(xb_ld(&bar[XB_XGEN(b.x)]) == gen, bar);
            __builtin_amdgcn_fence(__ATOMIC_ACQUIRE, "agent");
            asm volatile("s_waitcnt vmcnt(0)" ::: "memory");
        }
    }
    __syncthreads();
}

constexpr int NPHASE = 15;
#define PROBE_ATTN 0
#define PROBE_P1 0
#define PROBE_P0 0
#define PROBE_R2 0
#define PROBE_P56 0
#define PROBE_SYNC 0
#ifndef ONLY_PHASE
#define ONLY_PHASE -1
#endif
#define PH_ON(n) (ONLY_PHASE < 0 || ONLY_PHASE == (n))
__global__ void __launch_bounds__(512, 2) mega(Params p, int lo, int hi) {
    extern __shared__ __attribute__((aligned(16))) unsigned char shm[];
    cg::grid_group grid = cg::this_grid();
    LAS unsigned char* lds = (LAS unsigned char*)shm;
    unsigned char* ws = p.ws;
    bf16_t* H = (bf16_t*)(ws + O_H);
    volatile LAS unsigned* xst = (volatile LAS unsigned*)(shm + 131072);
    if (threadIdx.x == 0) { xst[0] = 0u; xst[1] = 0u; xst[2] = 0u; xst[3] = 0u; }
    __syncthreads();
    const XcdBarrier xb = xcd_barrier_post((unsigned*)(ws + O_BAR), xst);
    if (PH_ON(0) && lo <= 0 && 0 < hi) {
            float* tile = (float*)shm;
#if PROBE_P0
            int rep0 = -1; again0: ++rep0;
#endif
            conv_T<1>(p.in[3], 1024, DFF, (bf16_t*)(ws + O_WGU1), tile);
            conv_T<2>(p.in[4], 1024, DFF, (bf16_t*)(ws + O_WGU1), tile);
            conv_T<0>(p.in[5], DFF, 1024, (bf16_t*)(ws + O_WD1), tile);
            conv_T<4>(p.in[8], 1024, DIN, (bf16_t*)(ws + O_WIN), tile);
            conv_T<3>(p.in[28], 384, 768, (bf16_t*)(ws + O_WUQ), tile, p.in[27], p.in[27], 384);
            conv_T<0>(p.in[30], 256, 1024, (bf16_t*)(ws + O_WUKV), tile, p.in[29], p.in[29], 256);
            conv_T<0>(p.in[24], 512, 512, (bf16_t*)(ws + O_WGLU), tile);
            conv_T<0>(p.in[32], 1024, 1024, (bf16_t*)(ws + O_WOUT), tile, p.in[26], p.in[31], 512);
            { bf16_t* wp = (bf16_t*)(ws + O_WIN) + (size_t)DIN * 1024; for (int i = blockIdx.x * blockDim.x + threadIdx.x; i < (DINP - DIN) * 1024; i += gridDim.x * blockDim.x) wp[i] = 0; }
            { float* ssz = (float*)(ws + O_SS); for (int i = blockIdx.x * blockDim.x + threadIdx.x; i < 4 * T; i += gridDim.x * blockDim.x) ssz[i] = 0.f; }
            tables_phase0(p);
            rowpass_first(p);
#if PROBE_P0
            if (rep0 == 0) { __syncthreads(); goto again0; }
#endif
    }
    if (lo <= 0 && 1 < hi) xcd_barrier(xb);
    if (PH_ON(1) && lo <= 1 && 1 < hi) {
            ktab_phase(p);
            pg8::EpiSwiGLU E; E.O = (bf16_t*)(ws + O_A);
            run_gemm(lds, H, 1024, 0, (const bf16_t*)(ws + O_WGU1), 1024, 0, T, 5632, 1024, 1, E);
#if PROBE_P1
            run_gemm(lds, H, 1024, 0, (const bf16_t*)(ws + O_WGU1), 1024, 0, T, 5632, 1024, 1, E);
#endif
    }
    if (lo <= 1 && 2 < hi) xcd_barrier(xb);
    if (PH_ON(2) && lo <= 2 && 2 < hi) {
            pg8::EpiBf16 E; E.O = H; E.ldc = 1024;
            run_gemm(lds, (const bf16_t*)(ws + O_A), DFF, 0, (const bf16_t*)(ws + O_WD1), DFF, 0, T, 1024, DFF, 1, E);
    }
    if (lo <= 2 && 3 < hi) xcd_barrier(xb);
    if (PH_ON(3) && lo <= 3 && 3 < hi) {
                        rowpass_res<0>(p, H, 0.5f, p.in[6], p.in[7], H);
            expand_phase(p);
    }
    if (lo <= 3 && 4 < hi) xcd_barrier(xb);
    if (PH_ON(4) && lo <= 4 && 4 < hi) {
            pg8::EpiZ E; E.UA = (bf16_t*)(ws + O_UA); E.zq = (bf16_t*)(ws + O_ZQ); E.kpe = (bf16_t*)(ws + O_KPE); E.ssq = (float*)(ws + O_SSQ); E.rope = (const f32x2*)(ws + O_ROPE);
            run_gemm(lds, H, 1024, 0, (const bf16_t*)(ws + O_WIN), 1024, 0, T, DINP, 1024, 1, E);
    }
    if (lo <= 4 && 5 < hi) xcd_barrier(xb);
    if (PH_ON(5) && lo <= 5 && 5 < hi) {
            { pg8::EpiF32 E; E.C = (float*)(ws + O_S); E.ldc = 256; E.sC = (size_t)NCH * 256;
              run_gemm(lds, (const bf16_t*)(ws + O_UA), 768, (size_t)NCH * 768, (const bf16_t*)(ws + O_BS), 512, (size_t)256 * 512, NCH, 256, 512, 32, E); }
            asm volatile("s_waitcnt vmcnt(0)" ::: "memory"); __syncthreads(); __builtin_amdgcn_fence(__ATOMIC_ACQUIRE, "agent");
            for (int L = blockIdx.x; L < 32 * 6; L += gridDim.x) scan_unit(p, L / 6, L % 6);
            __syncthreads();
#ifndef NO_P6A
            { pg8::EpiQ E; E.Q = (bf16_t*)(ws + O_Q); E.rope = (const f32x2*)(ws + O_ROPE); E.qs = 0.10206207261596577f * 1.4426950408889634f; E.ssq = (const float*)(ws + O_SSQ);
              run_gemm(lds, (const bf16_t*)(ws + O_ZQ), 640, 0, (const bf16_t*)(ws + O_WUQ), 384, 0, T, 768, 384, 1, E, (int)(gridDim.x >> 2)); }
#endif
#ifndef NO_P6B
            { pg8::EpiKV E; E.Kn = (bf16_t*)(ws + O_KN); E.Vt = (bf16_t*)(ws + O_VT); E.sskv = (const float*)(ws + O_SSQ) + T;
              run_gemm(lds, (const bf16_t*)(ws + O_ZQ) + 384, 640, 0, (const bf16_t*)(ws + O_WUKV), 256, 0, T, 1024, 256, 1, E); }
#endif
    }
    if (lo <= 5 && 6 < hi) xcd_barrier(xb);
    if (PH_ON(7) && lo <= 7 && 7 < hi) {
            { pg8::EpiY E; E.yg = (bf16_t*)(ws + O_YG);
              run_gemm(lds, (const bf16_t*)(ws + O_UA), 768, (size_t)NCH * 768, (const bf16_t*)(ws + O_MY), 768, (size_t)512 * 768, NCH, 512, 768, 32, E); }
            if (threadIdx.x >= 256) __builtin_amdgcn_s_setprio(1);
            attn_phase(p, shm);
            __builtin_amdgcn_s_setprio(0);
#if PROBE_ATTN
            __syncthreads(); attn_phase(p, shm);
#endif
    }
    if (lo <= 7 && 8 < hi) xcd_barrier(xb);
    if (PH_ON(8) && lo <= 8 && 8 < hi) {
            { float* tile = (float*)shm;
              conv_T<1>(p.in[35], 1024, DFF, (bf16_t*)(ws + O_WGU2), tile);
              conv_T<2>(p.in[36], 1024, DFF, (bf16_t*)(ws + O_WGU2), tile);
              conv_T<0>(p.in[37], DFF, 1024, (bf16_t*)(ws + O_WD2), tile);
              __syncthreads(); }
            pg8::EpiGLU E; E.yg = (const bf16_t*)(ws + O_YG); E.bias = p.in[25]; E.cat = H; E.ss = (float*)(ws + O_SS);
            run_gemm(lds, (const bf16_t*)(ws + O_YG), 512, 0, (const bf16_t*)(ws + O_WGLU), 512, 0, T, 512, 512, 1, E);
    }
    if (lo <= 8 && 9 < hi) xcd_barrier(xb);
    if (PH_ON(9) && lo <= 9 && 9 < hi) {
    }
    if (PH_ON(10) && lo <= 10 && 10 < hi) {
            pg8::EpiOut E; E.O = (bf16_t*)(ws + O_M2); E.ss = (const float*)(ws + O_SS);
            run_gemm(lds, H, 1024, 0, (const bf16_t*)(ws + O_WOUT), 1024, 0, T, 1024, 1024, 1, E);
    }
    if (lo <= 10 && 11 < hi) xcd_barrier(xb);
    if (PH_ON(11) && lo <= 11 && 11 < hi) {
            rowpass_res<1>(p, (const bf16_t*)(ws + O_M2), 1.0f, p.in[33], p.in[34], H);
    }
    if (lo <= 11 && 12 < hi) xcd_barrier(xb);
    if (PH_ON(12) && lo <= 12 && 12 < hi) {
            pg8::EpiSwiGLU E; E.O = (bf16_t*)(ws + O_A2);
            run_gemm(lds, H, 1024, 0, (const bf16_t*)(ws + O_WGU2), 1024, 0, T, 5632, 1024, 1, E);
    }
    if (lo <= 12 && 13 < hi) xcd_barrier(xb);
    if (PH_ON(13) && lo <= 13 && 13 < hi) {
            pg8::EpiBf16 E; E.O = H; E.ldc = 1024;
            run_gemm(lds, (const bf16_t*)(ws + O_A2), DFF, 0, (const bf16_t*)(ws + O_WD2), DFF, 0, T, 1024, DFF, 1, E);
    }
    if (lo <= 13 && 14 < hi) xcd_barrier(xb);
    if (PH_ON(14) && lo <= 14 && 14 < hi) {
            rowpass_res<2>(p, H, 0.5f, p.in[38], nullptr, H);
    }
    if (hi > NPHASE) grid.sync();
}

extern "C" void kernel_launch(void* const* d_in, const int* in_sizes, int n_in, void* d_out, int out_size, void* d_ws, size_t ws_size, hipStream_t stream) {
    constexpr size_t kDynLds = 131072 + 16;
    static int grid_blocks = 0;
    if (!grid_blocks) {
        int dev = 0, cus = 0, per_cu = 0;
        hipGetDevice(&dev);
        hipDeviceGetAttribute(&cus, hipDeviceAttributeMultiprocessorCount, dev);
        hipFuncSetAttribute((const void*)mega, hipFuncAttributeMaxDynamicSharedMemorySize, (int)kDynLds);
        hipOccupancyMaxActiveBlocksPerMultiprocessor(&per_cu, mega, 512, kDynLds);
        if (per_cu < 1) per_cu = 1;
        if (per_cu > 1) per_cu = 1;
        grid_blocks = cus * per_cu;
    }
    if (ws_size < O_TOTAL || n_in < 39) { fprintf(stderr, "workspace too small: %zu < %zu\n", ws_size, (size_t)O_TOTAL); return; }
    Params p{};
    for (int i = 0; i < 39; ++i) p.in[i] = (const float*)d_in[i];
    p.out = (float*)d_out; p.ws = (unsigned char*)d_ws;
    int lo = 0, hi = NPHASE;
    hipMemsetAsync((unsigned char*)d_ws + O_BAR, 0, 16384, stream);
    void* args[] = {&p, &lo, &hi};
    hipError_t e = hipLaunchCooperativeKernel((const void*)mega, dim3(grid_blocks), dim3(512), args, kDynLds, stream);
    if (e != hipSuccess) fprintf(stderr, "cooperative launch failed: %s (grid %d)\n", hipGetErrorString(e), grid_blocks);
}
```
